# Optimizing an MI355X kernel written in HIP

```python
import math
import jax, jax.numpy as jnp
from jax import lax
import numpy as np

D_MODEL = 1024
BATCH = 2
SEQ = 8192
DEPTH = 2
DEC_BATCH = 16
DEC_SEQ = 64
PAST_LEN = 2048

CHUNK = 64
N_BAND_PAST = 8
BAND_PAST = N_BAND_PAST * CHUNK
N_HEADS_A = 8
HEAD_DIM = 64
D_ATTN = N_HEADS_A * HEAD_DIM
MAX_REL = 256
N_REL = 2 * MAX_REL + 1
D_RNN = 512
N_RNN_BLOCKS = 8
RNN_BLOCK = D_RNN // N_RNN_BLOCKS
CONV_W = 4
RG_C = 8.0
D_FF = 2816
FFN_CONV_W = 3
EPS = 1e-6
NEG_INF = -1e30
D_IN = 3 * D_ATTN + 2 * D_RNN + 2 * D_MODEL
SPLIT_POINTS = (D_ATTN, 2 * D_ATTN, 3 * D_ATTN, 3 * D_ATTN + D_RNN,
                3 * D_ATTN + 2 * D_RNN, 3 * D_ATTN + 2 * D_RNN + D_MODEL)

kernel_name = "hybrid_chunk_band_rglru_convffn_step"


def rmsnorm(x, g):
    xf = x.astype(jnp.float32)
    y = xf * lax.rsqrt(jnp.mean(xf * xf, axis=-1, keepdims=True) + EPS)
    return (y * g.astype(jnp.float32)).astype(x.dtype)


def adaln(c, w, b):
    m = jax.nn.silu(c) @ w + b
    return jnp.split(m, 3, axis=-1)


def modulate(x, g, shift, scale):
    return rmsnorm(x, g) * (1 + scale[:, None, :]) + shift[:, None, :]


def causal_dwconv(x, prev, w, b):
    width = w.shape[0]
    T = x.shape[1]
    xp = jnp.concatenate([prev, x], axis=1)
    y = b + sum(xp[:, j:j + T] * w[j] for j in range(width))
    return y, xp[:, xp.shape[1] - (width - 1):]


def band_bias(table, n_q, n_past, n_k):
    rel = n_past + jnp.arange(n_q)[:, None] - jnp.arange(n_k)[None, :]
    idx = jnp.clip(rel, -MAX_REL, MAX_REL) + MAX_REL
    return jnp.transpose(table[idx], (2, 0, 1))


def band_attend(q, kb, vb, bias, key_valid):
    s = jnp.einsum('bnthd,bnmhd->bnhtm', q, kb).astype(jnp.float32) * (HEAD_DIM ** -0.5)
    s = s + bias.astype(jnp.float32)[None, None]
    s = jnp.where(key_valid[None, :, None, None, :], s, NEG_INF)
    p = jax.nn.softmax(s, axis=-1).astype(vb.dtype)
    return jnp.einsum('bnhtm,bnmhd->bnthd', p, vb)


def mixer_a_prompt(q, k, v, table):
    B, S, H, dh = q.shape
    nc = S // CHUNK
    nb = N_BAND_PAST + 1
    pad = jnp.zeros((B, BAND_PAST, H, dh), k.dtype)
    kc = jnp.concatenate([pad, k], axis=1).reshape(B, nc + N_BAND_PAST, CHUNK, H, dh)
    vc = jnp.concatenate([pad, v], axis=1).reshape(B, nc + N_BAND_PAST, CHUNK, H, dh)
    idx = jnp.arange(nc)[:, None] + jnp.arange(nb)[None, :]
    kb = kc[:, idx].reshape(B, nc, nb * CHUNK, H, dh)
    vb = vc[:, idx].reshape(B, nc, nb * CHUNK, H, dh)
    valid = jnp.repeat(idx >= N_BAND_PAST, CHUNK, axis=1)
    bias = band_bias(table, CHUNK, BAND_PAST, nb * CHUNK)
    o = band_attend(q.reshape(B, nc, CHUNK, H, dh), kb, vb, bias, valid)
    rows = min(BAND_PAST, S)
    return o.reshape(B, S, H * dh), k[:, S - rows:], v[:, S - rows:]


def mixer_a_sample(q, k, v, past_k, past_v, table):
    B, T, H, dh = q.shape
    P = past_k.shape[1]
    kk = jnp.concatenate([past_k, k], axis=1)[:, None]
    vv = jnp.concatenate([past_v, v], axis=1)[:, None]
    valid = jnp.ones((1, P + T), dtype=bool)
    bias = band_bias(table, T, P, P + T)
    o = band_attend(q[:, None], kk, vv, bias, valid)[:, 0]
    return o.reshape(B, T, H * dh), k, v


def _lin_combine(left, right):
    a1, b1 = left
    a2, b2 = right
    return a1 * a2, a2 * b1 + b2


def rg_lru(x, h0, wa, ba, wx, bx, lam):
    B, T, _ = x.shape
    xb = x.reshape(B, T, N_RNN_BLOCKS, RNN_BLOCK)
    r = jax.nn.sigmoid((jnp.einsum('btni,nij->btnj', xb, wa).reshape(B, T, D_RNN) + ba).astype(jnp.float32))
    ig = jax.nn.sigmoid((jnp.einsum('btni,nij->btnj', xb, wx).reshape(B, T, D_RNN) + bx).astype(jnp.float32))
    log_a = -RG_C * r * jax.nn.softplus(-lam.astype(jnp.float32))
    a = jnp.exp(log_a)
    u = jnp.sqrt(-jnp.expm1(2.0 * log_a)) * (ig * x.astype(jnp.float32))
    u = u.at[:, 0].add(a[:, 0] * h0.astype(jnp.float32))
    _, hs = lax.associative_scan(_lin_combine, (a, u), axis=1)
    return hs.astype(x.dtype), hs[:, -1].astype(x.dtype)


def setup_inputs(seed: int = 0) -> dict:
    key = jax.random.key(seed)
    ks = iter(jax.random.split(key, 40))
    f32 = jnp.float32
    nrm = lambda shape, s: s * jax.random.normal(next(ks), shape, f32)
    a_rows = min(BAND_PAST, PAST_LEN)
    u = jax.random.uniform(next(ks), (DEPTH, D_RNN), f32, 0.9, 0.999)
    a0 = u ** (1.0 / RG_C)
    lam = jnp.log(a0) - jnp.log1p(-a0)
    return {
        "x_prompt": nrm((BATCH, SEQ, D_MODEL), 1.0),
        "x_sample": nrm((DEC_BATCH, DEC_SEQ, D_MODEL), 1.0),
        "c_prompt": nrm((BATCH, D_MODEL), 1.0),
        "c_sample": nrm((DEC_BATCH, D_MODEL), 1.0),
        "cache_k": nrm((DEPTH, DEC_BATCH, a_rows, N_HEADS_A, HEAD_DIM), 1.0),
        "cache_v": nrm((DEPTH, DEC_BATCH, a_rows, N_HEADS_A, HEAD_DIM), 1.0),
        "state_rnn_conv": nrm((DEPTH, DEC_BATCH, CONV_W - 1, D_RNN), 1.0),
        "state_rnn_h": nrm((DEPTH, DEC_BATCH, D_RNN), 0.5),
        "state_ffn_conv": nrm((DEPTH, DEC_BATCH, FFN_CONV_W - 1, 2 * D_FF), 1.0),
        "mod_mix_w": nrm((DEPTH, D_MODEL, 3 * D_MODEL), 0.5 * D_MODEL ** -0.5),
        "mod_mix_b": nrm((DEPTH, 3 * D_MODEL), 0.02),
        "norm_mix_g": 1.0 + nrm((DEPTH, D_MODEL), 0.05),
        "w_in": nrm((DEPTH, D_MODEL, D_IN), D_MODEL ** -0.5),
        "rel_bias_table": nrm((DEPTH, N_REL, N_HEADS_A), 0.2),
        "rnn_conv_w": nrm((DEPTH, CONV_W, D_RNN), CONV_W ** -0.5),
        "rnn_conv_b": nrm((DEPTH, D_RNN), 0.02),
        "rnn_gate_a_w": nrm((DEPTH, N_RNN_BLOCKS, RNN_BLOCK, RNN_BLOCK), RNN_BLOCK ** -0.5),
        "rnn_gate_a_b": nrm((DEPTH, D_RNN), 0.02),
        "rnn_gate_x_w": nrm((DEPTH, N_RNN_BLOCKS, RNN_BLOCK, RNN_BLOCK), RNN_BLOCK ** -0.5),
        "rnn_gate_x_b": nrm((DEPTH, D_RNN), 0.02),
        "rnn_lambda": lam,
        "w_branch": nrm((DEPTH, D_ATTN + D_RNN, D_MODEL), D_RNN ** -0.5),
        "w_out": nrm((DEPTH, D_MODEL, D_MODEL), D_MODEL ** -0.5),
        "mod_ffn_w": nrm((DEPTH, D_MODEL, 3 * D_MODEL), 0.5 * D_MODEL ** -0.5),
        "mod_ffn_b": nrm((DEPTH, 3 * D_MODEL), 0.02),
        "norm_ffn_g": 1.0 + nrm((DEPTH, D_MODEL), 0.05),
        "ffn_up_w": nrm((DEPTH, D_MODEL, 2 * D_FF), D_MODEL ** -0.5),
        "ffn_conv_w": nrm((DEPTH, FFN_CONV_W, 2 * D_FF), FFN_CONV_W ** -0.5),
        "ffn_conv_b": nrm((DEPTH, 2 * D_FF), 0.02),
        "ffn_down_w": nrm((DEPTH, D_FF, D_MODEL), D_FF ** -0.5),
        "final_norm_g": 1.0 + nrm((D_MODEL,), 0.05),
    }


def reference(x_prompt, x_sample, c_prompt, c_sample, cache_k, cache_v, state_rnn_conv,
              state_rnn_h, state_ffn_conv, mod_mix_w, mod_mix_b, norm_mix_g, w_in,
              rel_bias_table, rnn_conv_w, rnn_conv_b, rnn_gate_a_w, rnn_gate_a_b,
              rnn_gate_x_w, rnn_gate_x_b, rnn_lambda, w_branch, w_out, mod_ffn_w, mod_ffn_b,
              norm_ffn_g, ffn_up_w, ffn_conv_w, ffn_conv_b, ffn_down_w, final_norm_g):

    def run(x, c, past_k, past_v, conv_r, h_r, conv_f):
        B, T, _ = x.shape
        ks_, vs_, crs, hs_, cfs = [], [], [], [], []
        for l in range(DEPTH):
            shift, scale, gate = adaln(c, mod_mix_w[l], mod_mix_b[l])
            h = modulate(x, norm_mix_g[l], shift, scale)
            q, k, v, rx, rg, ga, gb = jnp.split(h @ w_in[l], SPLIT_POINTS, axis=-1)
            q = q.reshape(B, T, N_HEADS_A, HEAD_DIM)
            k = k.reshape(B, T, N_HEADS_A, HEAD_DIM)
            v = v.reshape(B, T, N_HEADS_A, HEAD_DIM)
            if past_k is None:
                attn, k_new, v_new = mixer_a_prompt(q, k, v, rel_bias_table[l])
                cr_prev = jnp.zeros((B, CONV_W - 1, D_RNN), x.dtype)
                h_prev = jnp.zeros((B, D_RNN), x.dtype)
                cf_prev = jnp.zeros((B, FFN_CONV_W - 1, 2 * D_FF), x.dtype)
            else:
                attn, k_new, v_new = mixer_a_sample(q, k, v, past_k[l], past_v[l], rel_bias_table[l])
                cr_prev, h_prev, cf_prev = conv_r[l], h_r[l], conv_f[l]
            xc, cr_new = causal_dwconv(rx, cr_prev, rnn_conv_w[l], rnn_conv_b[l])
            hseq, h_new = rg_lru(xc, h_prev, rnn_gate_a_w[l], rnn_gate_a_b[l],
                                 rnn_gate_x_w[l], rnn_gate_x_b[l], rnn_lambda[l])
            rnn = hseq * jax.nn.gelu(rg)
            merged = (jax.nn.sigmoid(ga) * (attn @ w_branch[l, :D_ATTN])
                      + jax.nn.sigmoid(gb) * (rnn @ w_branch[l, D_ATTN:]))
            x = x + gate[:, None, :] * (merged @ w_out[l])
            shift, scale, gate = adaln(c, mod_ffn_w[l], mod_ffn_b[l])
            h = modulate(x, norm_ffn_g[l], shift, scale)
            up, cf_new = causal_dwconv(h @ ffn_up_w[l], cf_prev, ffn_conv_w[l], ffn_conv_b[l])
            val, gt = jnp.split(up, 2, axis=-1)
            x = x + gate[:, None, :] * ((val * jax.nn.gelu(gt)) @ ffn_down_w[l])
            ks_.append(k_new); vs_.append(v_new); crs.append(cr_new); hs_.append(h_new); cfs.append(cf_new)
        y = rmsnorm(x, final_norm_g)
        return y, jnp.stack(ks_), jnp.stack(vs_), jnp.stack(crs), jnp.stack(hs_), jnp.stack(cfs)

    y_prompt, k_p, v_p, rc_p, h_p, fc_p = run(x_prompt, c_prompt, None, None, None, None, None)
    y_sample, k_s, v_s, rc_s, h_s, fc_s = run(x_sample, c_sample, cache_k, cache_v,
                                              state_rnn_conv, state_rnn_h, state_ffn_conv)
    return (y_prompt, y_sample, k_p, v_p, k_s, v_s, rc_p, rc_s, h_p, h_s, fc_p, fc_s)
```

```cpp
#include <hip/hip_runtime.h>
#include <hip/hip_cooperative_groups.h>
#include <cstdio>
#include <cstdint>
namespace cg = cooperative_groups;

#define LAS __attribute__((address_space(3)))
#define GAS __attribute__((address_space(1)))
typedef unsigned short bf16_t;
typedef short bf16x8 __attribute__((ext_vector_type(8)));
typedef float f32x4 __attribute__((ext_vector_type(4)));
typedef float f32x2 __attribute__((ext_vector_type(2)));
typedef float f32x16 __attribute__((ext_vector_type(16)));
typedef unsigned u32x4 __attribute__((ext_vector_type(4)));
typedef unsigned u32x2 __attribute__((ext_vector_type(2)));

constexpr int MT = 17408, MP = 16384, DM = 1024, NMAIN = 4096, DIN = 4608, DFF = 2816, DUP = 5632, HUP = 2816  , HF = 1408;
constexpr int NITEM_RNN = 272, NITEM_ATT = 544;
constexpr size_t OFF_Y = 0, OFF_KP = 17825792, OFF_VP = 18874368, OFF_KS = 19922944, OFF_VS = 20971520, OFF_RCP = 22020096, OFF_RCS = 22026240,
                 OFF_HP = 22075392, OFF_HS = 22077440, OFF_FCP = 22093824, OFF_FCS = 22138880;
constexpr size_t MiB = 1u << 20;
constexpr size_t WS_CTL = 0;
constexpr size_t WS_MODS = 64 * 1024;
constexpr size_t WS_AGGA = 1 * MiB, WS_AGGH = 2 * MiB;
constexpr size_t WS_WG = 3 * MiB;
constexpr size_t WS_CARRY = 3 * MiB + 256 * 1024;
constexpr size_t WS_WIN = 4 * MiB, WS_WBR = 13 * MiB, WS_WOUT = 15 * MiB, WS_WUP = 17 * MiB, WS_WDN = 28 * MiB;
constexpr size_t WS_KC = 34 * MiB, WS_VTC = 42 * MiB;
constexpr size_t WS_HEAD = 34 * MiB, WS_TAIL = 38 * MiB;
constexpr size_t WS_H = 50 * MiB;
constexpr size_t WS_QKG = 84 * MiB;
constexpr size_t WS_VT = 220 * MiB;
constexpr size_t WS_HL = 237 * MiB, WS_CA = 254 * MiB;
constexpr size_t WS_MG = 237 * MiB;
constexpr size_t WS_UP = 84 * MiB;
constexpr size_t WS_ACT = 178 * MiB;
constexpr size_t WS_KF = 272 * MiB;
constexpr size_t WS_NEED = 290 * MiB;
constexpr int LDS_XC_STRIDE = 516;
constexpr int LDS_TAB_OFF = 64 * LDS_XC_STRIDE * 4;
constexpr int LDS_TAB_STRIDE = 832;
constexpr int LDS_MISC_OFF = LDS_TAB_OFF + 8 * LDS_TAB_STRIDE * 4;
constexpr int LDS_BYTES = LDS_MISC_OFF + 64;

struct Params { const float* in[31]; float* out; unsigned char* ws; };


template <int OFF> __device__ __forceinline__ unsigned long long karg_u64() {
    auto ka = __builtin_amdgcn_kernarg_segment_ptr();
    unsigned long long v; asm volatile("s_load_dwordx2 %0, %1, %2\n\ts_waitcnt lgkmcnt(0)" : "=s"(v) : "s"(ka), "n"(OFF)); return v;
}
#define KIN(i) ((const float*)karg_u64<8 * (i)>())
#define KOUT ((float*)karg_u64<248>())
#define KWS ((unsigned char*)karg_u64<256>())
__device__ __forceinline__ unsigned cvt_pk_bf16(float lo, float hi) { unsigned r; asm volatile("v_cvt_pk_bf16_f32 %0, %1, %2" : "=v"(r) : "v"(lo), "v"(hi)); return r; }
__device__ __forceinline__ float bf2f(unsigned short b) { return __uint_as_float((unsigned)b << 16); }
__device__ __forceinline__ float bflo(unsigned w) { return __uint_as_float(w << 16); }
__device__ __forceinline__ float bfhi(unsigned w) { return __uint_as_float(w & 0xffff0000u); }
__device__ __forceinline__ float sigmoidf_(float x) { return __builtin_amdgcn_rcpf(1.0f + __expf(-x)); }
__device__ __forceinline__ float gelu_tanh(float x) { const float z = 1.5957691216057308f * (x + 0.044715f * x * x * x); return x * __builtin_amdgcn_rcpf(1.0f + __expf(-z)); }
__device__ __forceinline__ float wave_sum(float v) {
#pragma unroll
    for (int o = 1; o < 64; o <<= 1) v += __shfl_xor(v, o);
    return v;
}
#define LDS_WAIT() asm volatile("s_waitcnt lgkmcnt(0)" ::: "memory")
__device__ __forceinline__ int lane_id() { int r; asm volatile("v_mbcnt_lo_u32_b32 %0, -1, 0\n\tv_mbcnt_hi_u32_b32 %0, -1, %0" : "=v"(r)); return r; }

namespace pg8 {
constexpr int BM = 256, BK = 64, HALF = 128, HTB = HALF * BK * 2, STAGE_BYTES = 8 * HTB;
__device__ __forceinline__ int lds_byte(int r, int c) { const int st = (r >> 4) * 2 + (c >> 5), rr = r & 15, cc = c & 31, ob = rr * 64 + cc * 2; return st * 1024 + (ob ^ (((ob >> 9) & 1) << 5)); }
__device__ __forceinline__ void stage_rc(int b, int& R, int& C) { const int st = b / 1024, sb = b % 1024, swz = sb ^ (((sb >> 9) & 1) << 5); R = (st >> 1) * 16 + swz / 64; C = (st & 1) * 32 + (swz % 64) / 2; }
__device__ __forceinline__ int perm32(int rho) { const int n = rho >> 4, i = rho & 15; return 8 * (i >> 2) + 4 * n + (i & 3); }

struct Unit { int pm, pn, kind, nt; };

template <int nM, int nN, bool VT>
struct Sched {
    const char* A; const char* B; size_t tstep; int G, c, nt;
    static constexpr int nwg = nM * nN;
    __device__ __forceinline__ bool next(int i, Unit& u) const {
        const int L = i * G + c;
        int pm = 0, pn = 0, kind = 0; bool ok = true;
        if (L < nwg) {
            int wgid = L; { constexpr int q = nwg / 8, r = nwg % 8; const int xcd = wgid % 8, off = wgid / 8; wgid = (xcd < r ? xcd * (q + 1) : r * (q + 1) + (xcd - r) * q) + off; }
            constexpr int nig = 8 * nN; const int gid = wgid / nig, fm = gid * 8, gsz = (nM - fm) < 8 ? (nM - fm) : 8;
            pm = fm + ((wgid % nig) % gsz); pn = (wgid % nig) / gsz;
        } else {
            const int e = L - nwg;
            if (VT && e < 136) { kind = 1; pm = e & 1; pn = e >> 1; } else ok = false;
        }
        u.pm = pm; u.pn = pn; u.kind = kind; u.nt = nt;
        return ok;
    }
    __device__ __forceinline__ const char* abase(const Unit& u) const { if constexpr (VT) { if (u.kind) return B + (size_t)(16 + u.pm) * tstep; } return A + (size_t)u.pm * tstep; }
    __device__ __forceinline__ const char* bbase(const Unit& u) const { if constexpr (VT) { if (u.kind) return A + (size_t)u.pn * tstep; } return B + (size_t)u.pn * tstep; }
};
template <int NSL>
struct SchedSplit {
    const char* A; const char* B; size_t tstep; int G, c, K;
    __device__ __forceinline__ bool next(int i, Unit& u) const {
        const int L = i * G + c;
        int pm, pn, kind, ntl; bool ok = true;
        if (L < 256) {
            const int wgid = (L % 8) * 32 + L / 8, gid = wgid / 32;
            pm = gid * 8 + ((wgid % 32) % 8); pn = (wgid % 32) / 8; kind = 0; ntl = K / 64;
        } else {
            const int e = L - 256, un = e / NSL, sl = e % NSL;
            ok = e < 16 * NSL;
            pm = 64 + ((un >> 2) & 3); pn = (un & 3) | (sl << 8); kind = 1; ntl = K / NSL / 64;
        }
        u.pm = pm; u.pn = pn; u.kind = kind; u.nt = ntl;
        return ok;
    }
    __device__ __forceinline__ const char* abase(const Unit& u) const { return A + (size_t)u.pm * tstep + (size_t)(u.pn >> 8) * (K / NSL) * 2; }
    __device__ __forceinline__ const char* bbase(const Unit& u) const { return B + (size_t)(u.pn & 255) * tstep + (size_t)(u.pn >> 8) * (K / NSL) * 2; }
};

struct SchedPair {
    const char* A; const char* B; size_t tstep; int G, c;
    __device__ __forceinline__ bool next(int i, Unit& u) const {
        int pm, pn, kind, ntl; bool ok = true;
        if (i == 0) {
            const int wgid = (c % 8) * 32 + c / 8, gid = wgid / 32;
            pm = gid * 8 + ((wgid % 32) % 8); pn = (wgid % 32) / 8; kind = 0; ntl = 16; ok = c < 256;
        } else {
            const int e = (i - 1) * G + c, un = e >> 2, q = e & 3;
            ok = e < 64;
            pm = 64 + ((un >> 2) & 3); pn = (un & 3) | (q << 8); kind = 2; ntl = 4;
        }
        u.pm = pm; u.pn = pn; u.kind = kind; u.nt = ntl;
        return ok;
    }
    __device__ __forceinline__ const char* abase(const Unit& u) const { return A + (size_t)u.pm * tstep + (size_t)(u.pn >> 8) * 512; }
    __device__ __forceinline__ const char* bbase(const Unit& u) const { return B + (size_t)(u.pn & 255) * tstep + (size_t)(u.pn >> 8) * 512; }
};

struct SchedWout {
    const char* A; const char* TS; const char* B; size_t tstep; int G, c;
    __device__ __forceinline__ bool next(int i, Unit& u) const {
        const int L = i * G + c;
        int pm, pn, kind, ntl; bool ok = true;
        if (L < 256) {
            const int wgid = (L % 8) * 32 + L / 8, gid = wgid / 32;
            pm = gid * 8 + ((wgid % 32) % 8); pn = (wgid % 32) / 8; kind = 0; ntl = 16;
        } else {
            const int e = L - 256, un = e >> 4, r = e & 15;
            ok = e < 256;
            pm = 64 + ((un >> 2) & 3); pn = (un & 3) | (r << 8); kind = 1; ntl = 4;
        }
        u.pm = pm; u.pn = pn; u.kind = kind; u.nt = ntl;
        return ok;
    }
    __device__ __forceinline__ const char* abase(const Unit& u) const { const int r = u.pn >> 8; return u.kind ? TS + (size_t)(r >> 2) * (1024 * 1024 * 2) + (size_t)(u.pm - 64) * tstep + (size_t)(r & 3) * 512 : A + (size_t)u.pm * tstep; }
    __device__ __forceinline__ const char* bbase(const Unit& u) const { return B + (size_t)(u.pn & 255) * tstep + (size_t)((u.pn >> 8) & 3) * 512; }
};

template <class Epi, class SchedT>
__device__ __forceinline__ void gemm_phase(LAS unsigned char* lds, const int K, const SchedT& S, const Epi& E, const int wv) {
    const int tid_ = wv * 64 + lane_id();
    const int tid = tid_, wid = __builtin_amdgcn_readfirstlane(tid >> 6), lane = tid & 63, wr = wid >> 2, wc = wid & 3, fr = lane & 15, fq = lane >> 4;
    unsigned voffA0, voffA1, voffB0, voffB1;
    { int R, C; stage_rc(tid * 16, R, C); const int Rb = Epi::PERM ? ((R & ~31) + perm32(R & 31)) : R; voffA0 = (unsigned)(R * K + C) * 2u; voffB0 = (unsigned)(Rb * K + C) * 2u; }
    { int R, C; stage_rc(tid * 16 + 8192, R, C); const int Rb = Epi::PERM ? ((R & ~31) + perm32(R & 31)) : R; voffA1 = (unsigned)(R * K + C) * 2u; voffB1 = (unsigned)(Rb * K + C) * 2u; }
    const size_t kstep = (size_t)(BK * 2);
    const size_t hstep = (size_t)HALF * K * 2;
    const unsigned ldsw = (unsigned)wid * 1024u;
    const int aoff = lds_byte(wr * 64 + fr, fq * 8), boff = lds_byte(wc * 32 + fr, fq * 8);
#define PG8_SA(b, h) (((b) * 2 + (h)) * HTB)
#define PG8_SB(b, h) ((4 + (b) * 2 + (h)) * HTB)
#define PG8_STAGE(bufoff, gbase, voff) do { \
        __builtin_amdgcn_global_load_lds((const unsigned*)((const char*)(gbase) + voff##0), (LAS unsigned*)(lds + (bufoff) + ldsw), 16, 0, 0); \
        __builtin_amdgcn_global_load_lds((const unsigned*)((const char*)(gbase) + voff##1), (LAS unsigned*)(lds + (bufoff) + ldsw + 8192), 16, 0, 0); } while (0)
#define PG8_LDA(dst, b, h) do { _Pragma("unroll") for (int m = 0; m < 4; ++m) _Pragma("unroll") for (int k = 0; k < 2; ++k) dst[m][k] = *(const LAS bf16x8*)(lds + PG8_SA(b, h) + aoff + m * 2048 + k * 1024); } while (0)
#define PG8_LDB(dst, b, h) do { _Pragma("unroll") for (int n = 0; n < 2; ++n) _Pragma("unroll") for (int k = 0; k < 2; ++k) dst[n][k] = *(const LAS bf16x8*)(lds + PG8_SB(b, h) + boff + n * 2048 + k * 1024); } while (0)
#define PG8_MMA(ai, bj, At, Bt) do { __builtin_amdgcn_s_setprio(1); _Pragma("unroll") for (int m = 0; m < 4; ++m) _Pragma("unroll") for (int n = 0; n < 2; ++n) _Pragma("unroll") for (int k = 0; k < 2; ++k) \
        acc[ai][bj][m][n] = __builtin_amdgcn_mfma_f32_16x16x32_bf16(Bt[n][k], At[m][k], acc[ai][bj][m][n], 0, 0, 0); __builtin_amdgcn_s_setprio(0); } while (0)
#define PG8_WAIT_V(n) asm volatile("s_waitcnt vmcnt(" #n ")" ::: "memory")
#define PG8_WAIT_L(n) asm volatile("s_waitcnt lgkmcnt(" #n ")" ::: "memory")
#define PG8_BAR __builtin_amdgcn_s_barrier()
#define PG8_SCHED __builtin_amdgcn_sched_barrier(0)
    Unit cur, nxt; int ui = 0;
    if (!S.next(0, cur)) return;
    f32x4 acc[2][2][4][2];
#pragma unroll
    for (int a = 0; a < 2; ++a)
#pragma unroll
        for (int b = 0; b < 2; ++b)
#pragma unroll
            for (int m = 0; m < 4; ++m)
#pragma unroll
                for (int n = 0; n < 2; ++n) acc[a][b][m][n] = (f32x4){0.f, 0.f, 0.f, 0.f};
    bf16x8 At[4][2], B0[2][2], B1[2][2];
    const char* cA = S.abase(cur); const char* cB = S.bbase(cur);
    PG8_STAGE(PG8_SB(0, 0), cB, voffB); PG8_STAGE(PG8_SB(0, 1), cB + hstep, voffB); PG8_STAGE(PG8_SA(0, 0), cA, voffA); PG8_STAGE(PG8_SA(0, 1), cA + hstep, voffA);
    if (wr == 1) PG8_BAR;
    PG8_WAIT_V(2); PG8_BAR;
    PG8_STAGE(PG8_SB(1, 0), cB + kstep, voffB); PG8_STAGE(PG8_SA(1, 0), cA + kstep, voffA); PG8_STAGE(PG8_SB(1, 1), cB + hstep + kstep, voffB);
    PG8_WAIT_V(6); PG8_BAR;
    for (;;) {
        const bool has_next = S.next(ui + 1, nxt);
        const char* nA = has_next ? S.abase(nxt) : cA; const char* nB = has_next ? S.bbase(nxt) : cB;
        const int nt = cur.nt;
        for (int t = 0; t < nt; t += 2) {
            if constexpr (Epi::HAS_MID) { if (t == 8 && cur.kind == 0) E.mid(acc, cur, wr, wc, fr, fq); }
            const bool last = (t == nt - 2);
            const char* a1 = cA + (size_t)(t + 1) * kstep;
            const char* a2 = last ? nA : cA + (size_t)(t + 2) * kstep; const char* b2 = last ? nB : cB + (size_t)(t + 2) * kstep;
            const char* a3 = a2 + kstep; const char* b3 = b2 + kstep;
            PG8_LDB(B0, 0, 0); PG8_LDB(B1, 0, 1); PG8_SCHED; PG8_LDA(At, 0, 0); PG8_STAGE(PG8_SA(1, 1), a1 + hstep, voffA);
            PG8_WAIT_V(8); PG8_WAIT_L(0); PG8_BAR; PG8_MMA(0, 0, At, B0); PG8_MMA(0, 1, At, B1); PG8_BAR; PG8_SCHED;
            PG8_LDA(At, 0, 1); PG8_STAGE(PG8_SB(0, 0), b2, voffB); PG8_STAGE(PG8_SB(0, 1), b2 + hstep, voffB); PG8_STAGE(PG8_SA(0, 0), a2, voffA);
            PG8_WAIT_V(8); PG8_WAIT_L(0); PG8_BAR; PG8_MMA(1, 0, At, B0); PG8_MMA(1, 1, At, B1); PG8_BAR; PG8_SCHED;
            PG8_LDB(B0, 1, 0); PG8_LDB(B1, 1, 1); PG8_SCHED; PG8_LDA(At, 1, 0); PG8_STAGE(PG8_SA(0, 1), a2 + hstep, voffA);
            PG8_WAIT_V(8); PG8_WAIT_L(0); PG8_BAR; PG8_MMA(0, 0, At, B0); PG8_MMA(0, 1, At, B1); PG8_BAR; PG8_SCHED;
            PG8_LDA(At, 1, 1); PG8_STAGE(PG8_SB(1, 0), b3, voffB); PG8_STAGE(PG8_SB(1, 1), b3 + hstep, voffB); PG8_STAGE(PG8_SA(1, 0), a3, voffA);
            PG8_WAIT_V(8); PG8_WAIT_L(0); PG8_BAR; PG8_MMA(1, 0, At, B0); PG8_MMA(1, 1, At, B1); PG8_BAR; PG8_SCHED;
        }
        if (wr == 0) PG8_BAR;
        E(acc, cur, wr, wc, fr, fq);
        if (!has_next) break;
#pragma unroll
        for (int a = 0; a < 2; ++a)
#pragma unroll
            for (int b = 0; b < 2; ++b)
#pragma unroll
                for (int m = 0; m < 4; ++m)
#pragma unroll
                    for (int n = 0; n < 2; ++n) acc[a][b][m][n] = (f32x4){0.f, 0.f, 0.f, 0.f};
        cur = nxt; cA = nA; cB = nB; ++ui;
        if (wr == 1) PG8_BAR;
    }
    PG8_WAIT_V(0);
    PG8_BAR;
#undef PG8_SA
#undef PG8_SB
#undef PG8_STAGE
#undef PG8_LDA
#undef PG8_LDB
#undef PG8_MMA
#undef PG8_WAIT_V
#undef PG8_WAIT_L
#undef PG8_BAR
#undef PG8_SCHED
}
}
using pg8::Unit;

#define EPI_FENCE() asm volatile("" ::: "memory")
__device__ __forceinline__ u32x4 pack8(const f32x4 v0, const f32x4 v1) { u32x4 w; w.x = cvt_pk_bf16(v0[0], v0[1]); w.y = cvt_pk_bf16(v0[2], v0[3]); w.z = cvt_pk_bf16(v1[0], v1[1]); w.w = cvt_pk_bf16(v1[2], v1[3]); return w; }

struct EpiG1 {
    static constexpr bool PERM = true, HAS_MID = false;
    bf16_t* QKG; bf16_t* VT; bf16_t* KF; float* out; int l;
    __device__ __forceinline__ void operator()(const f32x4 (&acc)[2][2][4][2], const Unit& u, int wr, int wc, int fr, int fq) const {
        const int pm = u.pm, pn = u.pn;
        if (u.kind == 0) {
            const bool isK = (pn == 2 || pn == 3), isRx = (pn == 4 || pn == 5);
#pragma unroll
            for (int ai = 0; ai < 2; ++ai)
#pragma unroll
                for (int m = 0; m < 4; ++m) {
                    const int lrow = ai * 128 + wr * 64 + m * 16 + fr, row = pm * 256 + lrow;
#pragma unroll
                    for (int bj = 0; bj < 2; ++bj) {
                        const int c0 = pn * 256 + bj * 128 + wc * 32 + 8 * fq;
                        const f32x4 v0 = acc[ai][bj][m][0], v1 = acc[ai][bj][m][1];
                        if (isK) { const int hcol = c0 - 512, hh = hcol >> 6, d0 = hcol & 63, g = row >> 5, i = row & 31, slot = (i & 0x13) | ((i & 4) << 1) | ((i & 8) >> 1);
                            *(u32x4*)(KF + ((size_t)((g * 8 + hh) * 4 + (d0 >> 4))) * 512 + (((d0 >> 3) & 1) * 32 + slot) * 8) = pack8(v0, v1); }
                        else *(u32x4*)(QKG + (size_t)row * NMAIN + c0) = pack8(v0, v1);
                        if (isK) {
                            float* dst = nullptr;
                            if (pm < 64) { const int tl = pm & 31; if (tl >= 30) dst = out + OFF_KP + ((size_t)((l * 2 + (pm >> 5)) * 512 + (tl - 30) * 256 + lrow)) * 512 + (c0 - 512); }
                            else dst = out + OFF_KS + ((size_t)(l * 1024 + row - MP)) * 512 + (c0 - 512);
                            if (dst) { *(f32x4*)dst = v0; *(f32x4*)(dst + 4) = v1; }
                        }
                        if (isRx) {
                            float* dst = nullptr;
                            if (pm < 64) { if ((pm & 31) == 31 && lrow >= 253) dst = out + OFF_RCP + ((size_t)((l * 2 + (pm >> 5)) * 3 + (lrow - 253))) * 512 + (c0 - 1024); }
                            else { const int s = row - MP, t = s & 63; if (t >= 61) dst = out + OFF_RCS + ((size_t)((l * 16 + (s >> 6)) * 3 + (t - 61))) * 512 + (c0 - 1024); }
                            if (dst) { *(f32x4*)dst = v0; *(f32x4*)(dst + 4) = v1; }
                        }
                    }
                }
        } else {
            const bool qual = (pn >= 64) || ((pn & 31) >= 30);
#pragma unroll
            for (int ai = 0; ai < 2; ++ai)
#pragma unroll
                for (int m = 0; m < 4; ++m) {
                    const int hd = pm * 256 + ai * 128 + wr * 64 + m * 16 + fr;
#pragma unroll
                    for (int bj = 0; bj < 2; ++bj) {
                        const int t0 = pn * 256 + bj * 128 + wc * 32 + 8 * fq;
                        const f32x4 v0 = acc[ai][bj][m][0], v1 = acc[ai][bj][m][1];
                        { const int hh = hd >> 6, d = hd & 63, g = t0 >> 5;
                          *(u32x4*)(VT + ((size_t)((g * 8 + hh) * 4 + (d >> 5) * 2 + ((t0 >> 4) & 1))) * 512 + (((t0 >> 3) & 1) * 32 + (d & 31)) * 8) = pack8(v0, v1); }
                        if (qual) {
                            float* dst;
                            if (pn < 64) dst = out + OFF_VP + ((size_t)((l * 2 + (pn >> 5)) * 512 + ((t0 & 8191) - 7680))) * 512 + hd;
                            else dst = out + OFF_VS + ((size_t)(l * 1024 + t0 - MP)) * 512 + hd;
                            dst[0] = v0[0]; dst[512] = v0[1]; dst[1024] = v0[2]; dst[1536] = v0[3];
                            dst[2048] = v1[0]; dst[2560] = v1[1]; dst[3072] = v1[2]; dst[3584] = v1[3];
                        }
                    }
                }
        }
    }
};

struct EpiBr {
    static constexpr bool PERM = true, HAS_MID = true;
    const bf16_t* QKG; bf16_t* MG; bf16_t* TS;
    __device__ __forceinline__ void mid(f32x4 (&acc)[2][2][4][2], const Unit& u, int wr, int wc, int fr, int fq) const {
        const bf16_t* gbase = QKG + (size_t)(u.pm * 256 + wr * 64 + fr) * NMAIN + 2048 + u.pn * 256 + wc * 32 + 8 * fq;
        { unsigned long long g_ = (unsigned long long)gbase; asm volatile("" : "+v"(g_)); gbase = (const bf16_t*)g_; }
#pragma unroll
        for (int ai = 0; ai < 2; ++ai)
#pragma unroll
            for (int m = 0; m < 4; ++m) {
#pragma unroll
                for (int bj = 0; bj < 2; ++bj) {
                    const bf16_t* gp = gbase + (size_t)(ai * 128 + m * 16) * NMAIN + bj * 128;
                    const u32x4 ga = *(const GAS u32x4*)gp, gb = *(const GAS u32x4*)(gp + 1024);
#pragma unroll
                    for (int e = 0; e < 4; ++e) {
                        const float r0 = (1.0f + __expf(-fmaxf(bflo(gb[e]), -60.f))) * __builtin_amdgcn_rcpf(1.0f + __expf(-bflo(ga[e])));
                        const float r1 = (1.0f + __expf(-fmaxf(bfhi(gb[e]), -60.f))) * __builtin_amdgcn_rcpf(1.0f + __expf(-bfhi(ga[e])));
                        acc[ai][bj][m][e >> 1][(e & 1) * 2] *= r0; acc[ai][bj][m][e >> 1][(e & 1) * 2 + 1] *= r1;
                    }
                }
                EPI_FENCE();
            }
    }
    __device__ __forceinline__ void operator()(const f32x4 (&acc)[2][2][4][2], const Unit& u, int wr, int wc, int fr, int fq) const {
        const int q = u.pn >> 8, pnn = u.pn & 255;
        const int goff = (u.kind == 2 && (q >> 1) == 0) ? 2048 : 3072;
#pragma unroll
        for (int ai = 0; ai < 2; ++ai)
#pragma unroll
            for (int m = 0; m < 4; ++m) {
                const int row = u.pm * 256 + ai * 128 + wr * 64 + m * 16 + fr;
#pragma unroll
                for (int bj = 0; bj < 2; ++bj) {
                    const int c0 = pnn * 256 + bj * 128 + wc * 32 + 8 * fq;
                    const u32x4 gb = *(const u32x4*)(QKG + (size_t)row * NMAIN + goff + c0);
                    f32x4 v0 = acc[ai][bj][m][0], v1 = acc[ai][bj][m][1];
                    v0[0] *= sigmoidf_(fmaxf(bflo(gb[0]), -60.f)); v0[1] *= sigmoidf_(fmaxf(bfhi(gb[0]), -60.f)); v0[2] *= sigmoidf_(fmaxf(bflo(gb[1]), -60.f)); v0[3] *= sigmoidf_(fmaxf(bfhi(gb[1]), -60.f));
                    v1[0] *= sigmoidf_(fmaxf(bflo(gb[2]), -60.f)); v1[1] *= sigmoidf_(fmaxf(bfhi(gb[2]), -60.f)); v1[2] *= sigmoidf_(fmaxf(bflo(gb[3]), -60.f)); v1[3] *= sigmoidf_(fmaxf(bfhi(gb[3]), -60.f));
                    bf16_t* dst = u.kind == 2 ? TS + (size_t)q * 1024 * 1024 + (size_t)(row - MP) * DM + c0 : MG + (size_t)row * DM + c0;
                    *(u32x4*)dst = pack8(v0, v1);
                }
                EPI_FENCE();
            }
    }
};

struct EpiRes {
    static constexpr bool PERM = false, HAS_MID = false;
    const float* base_p; const float* base_s; float* X; const float* gate; bf16_t* part;
    __device__ __forceinline__ void operator()(const f32x4 (&acc)[2][2][4][2], const Unit& u, int wr, int wc, int fr, int fq) const {
        const int col0 = (u.pn & 255) * 256 + wc * 32 + 4 * fq;
#pragma unroll
        for (int ai = 0; ai < 2; ++ai)
#pragma unroll
            for (int m = 0; m < 4; ++m) {
                const int row = u.pm * 256 + ai * 128 + wr * 64 + m * 16 + fr;
                const int cb = row < MP ? (row >> 13) : 2 + ((row - MP) >> 6);
                const float* bp = row < MP ? base_p + (size_t)row * DM : base_s + (size_t)(row - MP) * DM;
                const float* gp = gate + cb * 3072;
#pragma unroll
                for (int bj = 0; bj < 2; ++bj)
#pragma unroll
                    for (int n = 0; n < 2; ++n) {
                        const int col = col0 + bj * 128 + n * 16;
                        const f32x4 g4 = *(const f32x4*)(gp + col);
                        float* xo = X + (size_t)row * DM + col;
                        if (u.kind) { const f32x4 v = g4 * acc[ai][bj][m][n]; u32x2 w; w.x = cvt_pk_bf16(v[0], v[1]); w.y = cvt_pk_bf16(v[2], v[3]);
                            *(u32x2*)(part + ((size_t)((u.pn >> 8) * 1024 + (row - MP))) * DM + col) = w; }
                        else { const f32x4 b4 = *(const f32x4*)(bp + col); *(f32x4*)xo = b4 + g4 * acc[ai][bj][m][n]; }
                    }
                EPI_FENCE();
            }
    }
};

__device__ __forceinline__ float dpp_ror1(float v) { return __builtin_bit_cast(float, __builtin_amdgcn_update_dpp(0, __builtin_bit_cast(int, v), 0x121, 0xf, 0xf, false)); }
__device__ __forceinline__ float dpp_shr1(float old, float v) { return __builtin_bit_cast(float, __builtin_amdgcn_update_dpp(__builtin_bit_cast(int, old), __builtin_bit_cast(int, v), 0x111, 0xf, 0xf, false)); }
__device__ __forceinline__ float dpp_shr2(float old, float v) { return __builtin_bit_cast(float, __builtin_amdgcn_update_dpp(__builtin_bit_cast(int, old), __builtin_bit_cast(int, v), 0x112, 0xf, 0xf, false)); }
__device__ __forceinline__ float dpp_ror2(float v) { return __builtin_bit_cast(float, __builtin_amdgcn_update_dpp(0, __builtin_bit_cast(int, v), 0x122, 0xf, 0xf, false)); }
struct EpiUpAct {
    static constexpr bool PERM = true, HAS_MID = false;
    bf16_t* ACT; float* out; float* HEAD; float* TAIL; const float* cw; const float* cb; const float* st; LAS float* hal; int l;
    __device__ __forceinline__ void operator()(const f32x4 (&acc)[2][2][4][2], const Unit& u, int wr, int wc, int fr, int fq) const {
        const int pm = u.pm, pn = u.pn;
        const int cl = wc * 32 + 8 * fq;
        const int jb = pn * 128 + cl;
        const bool samp = pm >= 64;
        if (fr >= 14) {
            const int rs = fr - 14;
#pragma unroll
            for (int ai = 0; ai < 2; ++ai) {
                float* fdst = nullptr;
                if (samp) fdst = out + OFF_FCS + ((size_t)((l * 16 + (pm - 64) * 4 + ai * 2 + wr) * 2 + rs)) * DUP;
                else if ((pm & 31) == 31 && ai == 1 && wr == 1) fdst = out + OFF_FCP + ((size_t)((l * 2 + (pm >> 5)) * 2 + rs)) * DUP;
                float* tdst = (!samp && ai == 1 && wr == 1) ? TAIL + ((size_t)(pm * 2 + rs)) * DUP : nullptr;
#pragma unroll
                for (int bj = 0; bj < 2; ++bj)
#pragma unroll
                    for (int n = 0; n < 2; ++n) {
                        const f32x4 v = acc[ai][bj][3][n];
                        *(LAS f32x4*)(hal + ((((ai * 2 + wr) * 2 + rs) * 2 + bj) * 128 + cl + 4 * n)) = v;
                        const int g = bj * DFF + jb + 4 * n;
                        if (fdst) *(f32x4*)(fdst + g) = v;
                        if (tdst) *(f32x4*)(tdst + g) = v;
                    }
            }
        }
        if (fr < 2 && !samp && wr == 0) {
            float* hdst = HEAD + ((size_t)(pm * 2 + fr)) * DUP;
#pragma unroll
            for (int bj = 0; bj < 2; ++bj)
#pragma unroll
                for (int n = 0; n < 2; ++n) *(f32x4*)(hdst + bj * DFF + jb + 4 * n) = acc[0][bj][0][n];
        }
        asm volatile("s_waitcnt lgkmcnt(0)" ::: "memory"); __builtin_amdgcn_s_barrier(); asm volatile("" ::: "memory");
#pragma unroll
        for (int n = 0; n < 2; ++n) {
            const int j0 = jb + 4 * n;
            const f32x4 wv0 = *(const f32x4*)(cw + j0), wv1 = *(const f32x4*)(cw + DUP + j0), wv2 = *(const f32x4*)(cw + 2 * DUP + j0), bv = *(const f32x4*)(cb + j0);
            const f32x4 wg0 = *(const f32x4*)(cw + DFF + j0), wg1 = *(const f32x4*)(cw + DUP + DFF + j0), wg2 = *(const f32x4*)(cw + 2 * DUP + DFF + j0), bg = *(const f32x4*)(cb + DFF + j0);
#pragma unroll
            for (int ai = 0; ai < 2; ++ai) {
                f32x4 h1v, h2v, h1g, h2g;
                if (samp) {
                    const float* sp = st + ((size_t)((l * 16 + (pm - 64) * 4 + ai * 2 + wr) * 2)) * DUP + j0;
                    h2v = *(const f32x4*)sp; h1v = *(const f32x4*)(sp + DUP); h2g = *(const f32x4*)(sp + DFF); h1g = *(const f32x4*)(sp + DUP + DFF);
                } else if (ai == 0 && wr == 0) {
                    h1v = h2v = h1g = h2g = (f32x4){0.f, 0.f, 0.f, 0.f};
                } else {
                    const int sb = (wr == 1) ? (ai * 2) : ((ai - 1) * 2 + 1);
                    const LAS float* hp = hal + (sb * 2 * 2 * 128 + cl + 4 * n);
                    h2v = *(const LAS f32x4*)(hp); h2g = *(const LAS f32x4*)(hp + 128); h1v = *(const LAS f32x4*)(hp + 256); h1g = *(const LAS f32x4*)(hp + 384);
                }
#pragma unroll
                for (int m = 0; m < 4; ++m) {
                    const f32x4 cv = acc[ai][0][m][n], cg = acc[ai][1][m][n];
                    float o[4];
#pragma unroll
                    for (int e = 0; e < 4; ++e) {
                        float p1v, p2v, p1g, p2g;
                        if (m > 0) {
                            const int mp = m > 0 ? m - 1 : 0;
                            p1v = dpp_shr1(dpp_ror1(acc[ai][0][mp][n][e]), cv[e]); p2v = dpp_shr2(dpp_ror2(acc[ai][0][mp][n][e]), cv[e]);
                            p1g = dpp_shr1(dpp_ror1(acc[ai][1][mp][n][e]), cg[e]); p2g = dpp_shr2(dpp_ror2(acc[ai][1][mp][n][e]), cg[e]);
                        } else {
                            p1v = dpp_shr1(h1v[e], cv[e]); p2v = dpp_shr2(fr == 0 ? h2v[e] : h1v[e], cv[e]);
                            p1g = dpp_shr1(h1g[e], cg[e]); p2g = dpp_shr2(fr == 0 ? h2g[e] : h1g[e], cg[e]);
                        }
                        const float val = bv[e] + wv0[e] * p2v + wv1[e] * p1v + wv2[e] * cv[e];
                        const float gt = bg[e] + wg0[e] * p2g + wg1[e] * p1g + wg2[e] * cg[e];
                        o[e] = val * gelu_tanh(gt);
                    }
                    const int row = pm * 256 + ai * 128 + wr * 64 + m * 16 + fr;
                    u32x2 w; w.x = cvt_pk_bf16(o[0], o[1]); w.y = cvt_pk_bf16(o[2], o[3]);
                    *(u32x2*)(ACT + (size_t)row * DFF + j0) = w;
                }
            }
        }
    }
};

__device__ __forceinline__ void ffn_fix_tile(const Params& P, int l, int pm, int tid) {
    const float* HEAD = (const float*)(KWS + WS_HEAD); const float* TAIL = (const float*)(KWS + WS_TAIL); bf16_t* ACT = (bf16_t*)(KWS + WS_ACT);
    const float* cw = KIN(27) + (size_t)l * 3 * DUP; const float* cb = KIN(28) + (size_t)l * DUP;
    for (int it = tid; it < DFF / 4; it += 512) {
        const int j0 = it * 4;
        const float* t0 = TAIL + ((size_t)((pm - 1) * 2)) * DUP + j0; const float* h0 = HEAD + ((size_t)(pm * 2)) * DUP + j0;
        const f32x4 tv0 = *(const f32x4*)t0, tv1 = *(const f32x4*)(t0 + DUP), tg0 = *(const f32x4*)(t0 + DFF), tg1 = *(const f32x4*)(t0 + DUP + DFF);
        const f32x4 hv0 = *(const f32x4*)h0, hv1 = *(const f32x4*)(h0 + DUP), hg0 = *(const f32x4*)(h0 + DFF), hg1 = *(const f32x4*)(h0 + DUP + DFF);
        const f32x4 wv0 = *(const f32x4*)(cw + j0), wv1 = *(const f32x4*)(cw + DUP + j0), wv2 = *(const f32x4*)(cw + 2 * DUP + j0), bv = *(const f32x4*)(cb + j0);
        const f32x4 wg0 = *(const f32x4*)(cw + DFF + j0), wg1 = *(const f32x4*)(cw + DUP + DFF + j0), wg2 = *(const f32x4*)(cw + 2 * DUP + DFF + j0), bg = *(const f32x4*)(cb + DFF + j0);
        const f32x4 v0 = bv + wv0 * tv0 + wv1 * tv1 + wv2 * hv0, g0 = bg + wg0 * tg0 + wg1 * tg1 + wg2 * hg0;
        const f32x4 v1 = bv + wv0 * tv1 + wv1 * hv0 + wv2 * hv1, g1 = bg + wg0 * tg1 + wg1 * hg0 + wg2 * hg1;
        u32x2 w0, w1;
        w0.x = cvt_pk_bf16(v0[0] * gelu_tanh(g0[0]), v0[1] * gelu_tanh(g0[1])); w0.y = cvt_pk_bf16(v0[2] * gelu_tanh(g0[2]), v0[3] * gelu_tanh(g0[3]));
        w1.x = cvt_pk_bf16(v1[0] * gelu_tanh(g1[0]), v1[1] * gelu_tanh(g1[1])); w1.y = cvt_pk_bf16(v1[2] * gelu_tanh(g1[2]), v1[3] * gelu_tanh(g1[3]));
        *(u32x2*)(ACT + (size_t)(pm * 256) * DFF + j0) = w0; *(u32x2*)(ACT + (size_t)(pm * 256 + 1) * DFF + j0) = w1;
    }
}

template <class RowMap>
__device__ __forceinline__ void transpose_item(const float* W, int K, int N, bf16_t* WT, const RowMap& rm, LAS float* scr, int item, int lane) {
    const int nblk = N / 32, kb = item / nblk, nb = item % nblk, k0 = 64 * kb, n0 = 32 * nb;
#pragma unroll
    for (int i = 0; i < 32; ++i) { const int kk = 2 * i + (lane >> 5); scr[kk * 33 + (lane & 31)] = W[(size_t)(k0 + kk) * N + n0 + (lane & 31)]; }
    LDS_WAIT(); asm volatile("" ::: "memory");
    const int c = lane & 7;
    const int d0 = rm(n0);
#pragma unroll
    for (int j = 0; j < 4; ++j) { const int n = (lane >> 3) + 8 * j; const LAS float* s = scr + (8 * c) * 33 + n;
        u32x4 o; o.x = cvt_pk_bf16(s[0 * 33], s[1 * 33]); o.y = cvt_pk_bf16(s[2 * 33], s[3 * 33]); o.z = cvt_pk_bf16(s[4 * 33], s[5 * 33]); o.w = cvt_pk_bf16(s[6 * 33], s[7 * 33]);
        *(u32x4*)(WT + (size_t)(d0 + n) * K + k0 + 8 * c) = o; }
    LDS_WAIT(); asm volatile("" ::: "memory");
}
template <class RowMap>
__device__ __forceinline__ void transpose_block(const float* W, int K, int N, bf16_t* WT, const RowMap& rm, LAS float* tile, int item, int tid) {
    const int nblk = N >> 7, kb = item / nblk, nb = item % nblk, k0 = kb << 7, n0 = nb << 7;
    const int rr = tid >> 5, c4 = (tid & 31) * 4;
    f32x4 v[8];
#pragma unroll
    for (int i = 0; i < 8; ++i) v[i] = __builtin_nontemporal_load((const GAS f32x4*)(W + (size_t)(k0 + rr + 16 * i) * N + n0 + c4));
    __syncthreads();
#pragma unroll
    for (int i = 0; i < 8; ++i) { LAS float* d = tile + (rr + 16 * i) * 129 + c4; d[0] = v[i][0]; d[1] = v[i][1]; d[2] = v[i][2]; d[3] = v[i][3]; }
    __syncthreads();
    const int d0 = rm(n0), c = tid & 15;
#pragma unroll
    for (int p = 0; p < 4; ++p) {
        const int n = (tid >> 4) + 32 * p; const LAS float* sp = tile + (8 * c) * 129 + n;
        u32x4 o; o.x = cvt_pk_bf16(sp[0], sp[129]); o.y = cvt_pk_bf16(sp[2 * 129], sp[3 * 129]); o.z = cvt_pk_bf16(sp[4 * 129], sp[5 * 129]); o.w = cvt_pk_bf16(sp[6 * 129], sp[7 * 129]);
        *(GAS u32x4*)(WT + (size_t)(d0 + n) * K + k0 + 8 * c) = o;
    }
}
struct MapId { __device__ __forceinline__ int operator()(int n0) const { return n0; } };
struct MapWin { __device__ __forceinline__ int operator()(int n0) const { return n0 < 1024 ? n0 : (n0 < 1536 ? 4096 + (n0 - 1024) : n0 - 512); } };
struct MapWup { __device__ __forceinline__ int operator()(int n0) const { const int gate = n0 >= DFF, j = n0 - gate * DFF; return 256 * (j >> 7) + 128 * gate + (j & 127); } };

__device__ __forceinline__ void convert_layer(const Params& P, int l, LAS unsigned char* lds, int gw, int NGW, int wave, int lane) {
    unsigned char* ws = KWS;
    {
        constexpr int I_IN = 8 * 36, I_BR = 8 * 8, I_OUT = 8 * 8, I_UP = 8 * 44, I_DN = 22 * 8;
        constexpr int NIT = I_IN + I_BR + I_OUT + I_UP + I_DN;
        LAS float* tile = (LAS float*)lds;
        const int tid = wave * 64 + lane;
        const int first = (l == 0 && gridDim.x == 256) ? 64 : 0;
        for (int it = (first && blockIdx.x >= 192) ? (int)blockIdx.x - 192 : first + (int)blockIdx.x; it < NIT; it = (it < first ? first + (int)blockIdx.x : it + (int)gridDim.x)) {
            int r = it;
            if (r < I_IN) { transpose_block(KIN(12) + (size_t)l * DM * DIN, DM, DIN, (bf16_t*)(ws + WS_WIN), MapWin(), tile, r, tid); continue; } r -= I_IN;
            if (r < I_BR) { transpose_block(KIN(21) + (size_t)l * DM * DM, DM, DM, (bf16_t*)(ws + WS_WBR), MapId(), tile, r, tid); continue; } r -= I_BR;
            if (r < I_OUT) { transpose_block(KIN(22) + (size_t)l * DM * DM, DM, DM, (bf16_t*)(ws + WS_WOUT), MapId(), tile, r, tid); continue; } r -= I_OUT;
            if (r < I_UP) { transpose_block(KIN(26) + (size_t)l * DM * DUP, DM, DUP, (bf16_t*)(ws + WS_WUP), MapWup(), tile, r, tid); continue; } r -= I_UP;
            transpose_block(KIN(29) + (size_t)l * DFF * DM, DFF, DM, (bf16_t*)(ws + WS_WDN), MapId(), tile, r, tid);
        }
        __syncthreads();
    }
    const float* wga_ = KIN(16); const float* wgx_ = KIN(18);
    for (int i = gw * 64 + lane; i < 8 * 2 * 4 * 2 * 64; i += NGW * 64) {
        const int ln = i & 63, ks = (i >> 6) & 1, jb = (i >> 7) & 3, gsel = (i >> 9) & 1, n = i >> 10, fr = ln & 15, fq = ln >> 4;
        const float* wg = (gsel ? wgx_ : wga_) + ((size_t)(l * 8 + n)) * 64 * 64;
        float f[8];
#pragma unroll
        for (int e = 0; e < 8; ++e) f[e] = wg[(ks * 32 + fq * 8 + e) * 64 + jb * 16 + fr];
        u32x4 w; w.x = cvt_pk_bf16(f[0], f[1]); w.y = cvt_pk_bf16(f[2], f[3]); w.z = cvt_pk_bf16(f[4], f[5]); w.w = cvt_pk_bf16(f[6], f[7]);
        *(u32x4*)(ws + WS_WG + (size_t)i * 16) = w;
    }
    const float* ck = KIN(4) + (size_t)l * 16 * 512 * 512; bf16_t* kc = (bf16_t*)(ws + WS_KC);
    const float* cv = KIN(5) + (size_t)l * 16 * 512 * 512; bf16_t* vc = (bf16_t*)(ws + WS_VTC);
    const int gt = gw * 64 + lane, NGT = NGW * 64;
#pragma unroll 2
    for (int i = gt; i < 16 * 16 * 8 * 4 * 64; i += NGT) {
        const int ln = i & 63, ks = (i >> 6) & 3, hh = (i >> 8) & 7, tile = (i >> 11) & 15, b = i >> 15;
        const int sl = ln & 31, r = tile * 32 + ((sl & 0x13) | ((sl & 4) << 1) | ((sl & 8) >> 1));
        const float* p = ck + ((size_t)(b * 512 + r)) * 512 + hh * 64 + ks * 16 + (ln >> 5) * 8;
        *(u32x4*)(kc + (size_t)i * 8) = pack8(__builtin_nontemporal_load((const f32x4*)p), __builtin_nontemporal_load((const f32x4*)(p + 4)));
    }
#pragma unroll 2
    for (int i = gt; i < 16 * 16 * 8 * 4 * 64; i += NGT) {
        const int ln = i & 63, q = (i >> 6) & 3, hh = (i >> 8) & 7, tile = (i >> 11) & 15, b = i >> 15;
        const int d = 32 * (q >> 1) + (ln & 31), r0 = tile * 32 + 16 * (q & 1) + 8 * (ln >> 5);
        const float* p = cv + ((size_t)(b * 512 + r0)) * 512 + hh * 64 + d;
        u32x4 w; w.x = cvt_pk_bf16(__builtin_nontemporal_load(p), __builtin_nontemporal_load(p + 512)); w.y = cvt_pk_bf16(__builtin_nontemporal_load(p + 1024), __builtin_nontemporal_load(p + 1536));
        w.z = cvt_pk_bf16(__builtin_nontemporal_load(p + 2048), __builtin_nontemporal_load(p + 2560)); w.w = cvt_pk_bf16(__builtin_nontemporal_load(p + 3072), __builtin_nontemporal_load(p + 3584));
        *(u32x4*)(vc + (size_t)i * 8) = w;
    }
}

__device__ __forceinline__ void mods_phase(const Params& P, LAS unsigned char* lds, int tid, int wave, int lane) {
    LAS float* sT = (LAS float*)lds;
    LAS float* red = (LAS float*)(lds + 81920);
    float* mods = (float*)(KWS + WS_MODS);
    for (int it = blockIdx.x; it < 192; it += gridDim.x) {
        const int lk = it / 48, cbk = it % 48, l = lk >> 1, kind = lk & 1, col0 = cbk * 64;
        const float* W = (kind ? KIN(23) : KIN(9)) + (size_t)l * DM * 3072;
        const float* bias = (kind ? KIN(24) : KIN(10)) + (size_t)l * 3072;
        __syncthreads();
        const float* cp_ = KIN(2); const float* cs_ = KIN(3);
        for (int i = tid; i < 18 * 1024; i += 512) { const int r = i >> 10, k = i & 1023; const float c = r < 2 ? cp_[r * 1024 + k] : cs_[(r - 2) * 1024 + k]; sT[k * 20 + r] = c * __builtin_amdgcn_rcpf(1.0f + __expf(-c)); }
        __syncthreads();
        float acc[18];
#pragma unroll
        for (int r = 0; r < 18; ++r) acc[r] = 0.f;
        const int kb = wave * 128;
#pragma unroll 16
        for (int k = 0; k < 128; ++k) {
            const float w = __builtin_nontemporal_load(W + (size_t)(kb + k) * 3072 + col0 + lane);
            const LAS f32x4* sp = (const LAS f32x4*)(sT + (kb + k) * 20);
            const f32x4 s0 = sp[0], s1 = sp[1], s2 = sp[2], s3 = sp[3]; const f32x2 s4 = *(const LAS f32x2*)(sT + (kb + k) * 20 + 16);
            acc[0] += s0[0] * w; acc[1] += s0[1] * w; acc[2] += s0[2] * w; acc[3] += s0[3] * w;
            acc[4] += s1[0] * w; acc[5] += s1[1] * w; acc[6] += s1[2] * w; acc[7] += s1[3] * w;
            acc[8] += s2[0] * w; acc[9] += s2[1] * w; acc[10] += s2[2] * w; acc[11] += s2[3] * w;
            acc[12] += s3[0] * w; acc[13] += s3[1] * w; acc[14] += s3[2] * w; acc[15] += s3[3] * w;
            acc[16] += s4[0] * w; acc[17] += s4[1] * w;
        }
#pragma unroll
        for (int r = 0; r < 18; ++r) red[(wave * 18 + r) * 64 + lane] = acc[r];
        __syncthreads();
        for (int o = tid; o < 18 * 64; o += 512) {
            const int r = o >> 6, cl = o & 63; float s = bias[col0 + cl];
#pragma unroll
            for (int w = 0; w < 8; ++w) s += red[(w * 18 + r) * 64 + cl];
            mods[((size_t)lk * 18 + r) * 3072 + col0 + cl] = s;
        }
    }
    __syncthreads();
}

__device__ __forceinline__ void norm_phase(const float* xp, const float* xs, const float* g, const float* mod  , bf16_t* H, float* xcopy  , const bf16_t* part, int nsl  , int gw, int NGW, int lane_) {
    int lane = lane_; asm volatile("" : "+v"(lane));
    auto rowptr = [&](int row) { return row < MP ? xp + (size_t)row * DM : xs + (size_t)(row - MP) * DM; };
    auto finish = [&](int row, f32x4 (&v)[4]) {
        const float* xr = rowptr(row);
        const int cb = row < MP ? (row >> 13) : 2 + ((row - MP) >> 6);
        const float* sh = mod + cb * 3072; const float* sc = sh + 1024;
        if (nsl > 0 && row >= MP) {
#pragma unroll
            for (int j = 0; j < 4; ++j) {
                const bf16_t* pp = part + (size_t)(row - MP) * DM + 4 * lane + 256 * j;
                for (int sl = 0; sl < nsl; ++sl) { const u32x2 w = *(const u32x2*)(pp + (size_t)sl * 1024 * DM); v[j][0] += bflo(w.x); v[j][1] += bfhi(w.x); v[j][2] += bflo(w.y); v[j][3] += bfhi(w.y); }
                *(f32x4*)((float*)xr + 4 * lane + 256 * j) = v[j];
            }
        }
        if (xcopy && row >= MP) {
#pragma unroll
            for (int j = 0; j < 4; ++j) *(f32x4*)(xcopy + (size_t)row * DM + 4 * lane + 256 * j) = v[j];
        }
        float s = 0.f;
#pragma unroll
        for (int j = 0; j < 4; ++j) s += (v[j][0] * v[j][0] + v[j][1] * v[j][1]) + (v[j][2] * v[j][2] + v[j][3] * v[j][3]);
        const float rstd = rsqrtf(wave_sum(s) * (1.0f / DM) + 1e-6f);
#pragma unroll
        for (int j = 0; j < 4; ++j) {
            const int c = 4 * lane + 256 * j;
            const f32x4 g4 = *(const f32x4*)(g + c), s4 = *(const f32x4*)(sh + c), c4 = *(const f32x4*)(sc + c);
            const f32x4 o = (v[j] * rstd * g4) * (c4 + 1.0f) + s4;
            u32x2 w; w.x = cvt_pk_bf16(o[0], o[1]); w.y = cvt_pk_bf16(o[2], o[3]);
            *(u32x2*)(H + (size_t)row * DM + c) = w;
        }
    };
    int row = gw;
    for (; row + NGW < MT; row += 2 * NGW) {
        const float* xa = rowptr(row); const float* xb = rowptr(row + NGW);
        f32x4 va[4], vb[4];
#pragma unroll
        for (int j = 0; j < 4; ++j) { va[j] = __builtin_nontemporal_load((const f32x4*)(xa + 4 * lane + 256 * j)); vb[j] = __builtin_nontemporal_load((const f32x4*)(xb + 4 * lane + 256 * j)); }
        finish(row, va); finish(row + NGW, vb);
    }
    if (row < MT) {
        const float* xa = rowptr(row);
        f32x4 va[4];
#pragma unroll
        for (int j = 0; j < 4; ++j) va[j] = __builtin_nontemporal_load((const f32x4*)(xa + 4 * lane + 256 * j));
        finish(row, va);
    }
}

__device__ __forceinline__ void rnn_item(const Params& P, int l, int item, LAS unsigned char* lds, unsigned* cnt, int tid_, int wave, int lane_) {
    int tid = tid_, lane = lane_; asm volatile("" : "+v"(tid), "+v"(lane));
    LAS float* xc = (LAS float*)lds;
    const bf16_t* QKG = (const bf16_t*)(KWS + WS_QKG);
    bf16_t* HL = (bf16_t*)(KWS + WS_HL); bf16_t* CA = (bf16_t*)(KWS + WS_CA);
    const int seq = item < 256 ? (item >> 7) : 2 + (item - 256), chunk = item < 256 ? (item & 127) : 0;
    const int rowbase = seq < 2 ? seq * 8192 + chunk * 64 : MP + (seq - 2) * 64;
    LDS_WAIT(); asm volatile("" ::: "memory");
    {
        const int ch = tid;
        const float* cw = KIN(14) + (size_t)l * 4 * 512; const float w0 = cw[ch], w1 = cw[512 + ch], w2 = cw[1024 + ch], w3 = cw[1536 + ch], cbias = KIN(15)[l * 512 + ch];
        float x0, x1, x2;
        if (seq < 2) {
            if (chunk == 0) { x0 = x1 = x2 = 0.f; }
            else { const bf16_t* p = QKG + (size_t)(rowbase - 3) * NMAIN + 1024 + ch; x0 = bf2f(p[0]); x1 = bf2f(p[NMAIN]); x2 = bf2f(p[2 * NMAIN]); }
        } else { const float* st = KIN(6) + ((size_t)(l * 16 + (seq - 2)) * 3) * 512 + ch; x0 = st[0]; x1 = st[512]; x2 = st[1024]; }
        {
            const int rr = lane >> 3, cc = lane & 7;
            const bf16_t* p = QKG + (size_t)(rowbase + rr) * NMAIN + 1024 + wave * 64 + cc * 8;
            u32x4 raw[8];
#pragma unroll
            for (int i = 0; i < 8; ++i) raw[i] = *(const GAS u32x4*)(p + (size_t)(8 * i) * NMAIN);
#pragma unroll
            for (int i = 0; i < 8; ++i) {
                LAS float* d = xc + (8 * i + rr) * LDS_XC_STRIDE + wave * 64 + cc * 8;
                *(LAS f32x4*)d = (f32x4){bflo(raw[i][0]), bfhi(raw[i][0]), bflo(raw[i][1]), bfhi(raw[i][1])};
                *(LAS f32x4*)(d + 4) = (f32x4){bflo(raw[i][2]), bfhi(raw[i][2]), bflo(raw[i][3]), bfhi(raw[i][3])};
            }
        }
        LDS_WAIT(); asm volatile("" ::: "memory");
        {
            LAS float* col = xc + ch;
            float r3 = col[63 * LDS_XC_STRIDE], r2 = col[62 * LDS_XC_STRIDE], r1 = col[61 * LDS_XC_STRIDE];
#pragma unroll 8
            for (int t = 63; t >= 0; --t) {
                const float r0 = t >= 3 ? col[(t - 3) * LDS_XC_STRIDE] : (t == 2 ? x2 : (t == 1 ? x1 : x0));
                col[t * LDS_XC_STRIDE] = cbias + w0 * r0 + w1 * r1 + w2 * r2 + w3 * r3;
                r3 = r2; r2 = r1; r1 = r0;
            }
        }
    }
    LDS_WAIT(); asm volatile("" ::: "memory");
    const int n = wave, fr = lane & 15, fq = lane >> 4;
    bf16x8 Bw[2][4][2];
    const unsigned char* wgp_ = KWS + WS_WG;
#pragma unroll
    for (int gsel = 0; gsel < 2; ++gsel)
#pragma unroll
        for (int jb = 0; jb < 4; ++jb)
#pragma unroll
            for (int ks = 0; ks < 2; ++ks) Bw[gsel][jb][ks] = *(const bf16x8*)(wgp_ + ((size_t)((((n * 2 + gsel) * 4 + jb) * 2 + ks) * 64 + lane)) * 16);
    float ba[4], bx[4], spl[4];
    const float* bap_ = KIN(17) + l * 512; const float* bxp_ = KIN(19) + l * 512; const float* lmp_ = KIN(20) + l * 512;
#pragma unroll
    for (int jb = 0; jb < 4; ++jb) { const int ch = n * 64 + jb * 16 + fr; ba[jb] = bap_[ch]; bx[jb] = bxp_[ch];
        const float lam = lmp_[ch]; spl[jb] = -8.0f * (lam > 15.f ? __expf(-lam) : log1pf(__expf(-lam))); }
    float hblk[4] = {0.f, 0.f, 0.f, 0.f}, cblk[4] = {1.f, 1.f, 1.f, 1.f};
#pragma unroll 1
    for (int tb = 0; tb < 4; ++tb) {
        bf16x8 Af[2];
#pragma unroll
        for (int ks = 0; ks < 2; ++ks) {
            const LAS float* xp = xc + (tb * 16 + fr) * LDS_XC_STRIDE + n * 64 + ks * 32 + fq * 8;
            const f32x4 a = *(const LAS f32x4*)xp, b = *(const LAS f32x4*)(xp + 4);
            const u32x4 w = pack8(a, b); Af[ks] = __builtin_bit_cast(bf16x8, w);
        }
#pragma unroll
        for (int jb = 0; jb < 4; ++jb) {
            f32x4 ga = {0.f, 0.f, 0.f, 0.f}, gx = {0.f, 0.f, 0.f, 0.f};
#pragma unroll
            for (int ks = 0; ks < 2; ++ks) { ga = __builtin_amdgcn_mfma_f32_16x16x32_bf16(Af[ks], Bw[0][jb][ks], ga, 0, 0, 0); gx = __builtin_amdgcn_mfma_f32_16x16x32_bf16(Af[ks], Bw[1][jb][ks], gx, 0, 0, 0); }
            const int ch = n * 64 + jb * 16 + fr;
            float a[4], uu[4];
#pragma unroll
            for (int r = 0; r < 4; ++r) {
                const int t = tb * 16 + fq * 4 + r;
                const float xv = xc[t * LDS_XC_STRIDE + ch];
                const float rr = sigmoidf_(ga[r] + ba[jb]), ig = sigmoidf_(gx[r] + bx[jb]);
                const float la = spl[jb] * rr;
                a[r] = __expf(la);
                const float y = -2.0f * la;
                const float om = y < 0.25f ? y * (1.0f + y * (-0.5f + y * (0.16666667f + y * (-0.041666668f + y * 0.0083333338f)))) : 1.0f - a[r] * a[r];
                uu[r] = __builtin_amdgcn_sqrtf(fmaxf(om, 0.f)) * (ig * xv);
            }
            float A4 = a[0], U4 = uu[0];
#pragma unroll
            for (int r = 1; r < 4; ++r) { U4 = a[r] * U4 + uu[r]; A4 *= a[r]; }
            float Ai = A4, Ui = U4;
            { const float Ap = __shfl_up(Ai, 16), Up = __shfl_up(Ui, 16); if (fq >= 1) { Ui = Ai * Up + Ui; Ai = Ap * Ai; } }
            { const float Ap = __shfl_up(Ai, 32), Up = __shfl_up(Ui, 32); if (fq >= 2) { Ui = Ai * Up + Ui; Ai = Ap * Ai; } }
            float Ae = __shfl_up(Ai, 16), Ue = __shfl_up(Ui, 16); if (fq == 0) { Ae = 1.f; Ue = 0.f; }
            const float Atot = __shfl(Ai, 48 + fr), Utot = __shfl(Ui, 48 + fr);
            float h = Ae * hblk[jb] + Ue, c = cblk[jb] * Ae;
#pragma unroll
            for (int r = 0; r < 4; ++r) {
                h = a[r] * h + uu[r]; c *= a[r];
                const size_t o = (size_t)(rowbase + tb * 16 + fq * 4 + r) * 512 + ch;
                ((unsigned*)HL)[o] = cvt_pk_bf16(h, c);
            }
            hblk[jb] = Atot * hblk[jb] + Utot; cblk[jb] *= Atot;
        }
    }
    if (seq >= 2) {
        if (fq == 0) {
            const float* h0 = KIN(7) + (size_t)(l * 16 + (seq - 2)) * 512; float* ho = KOUT + OFF_HS + (size_t)(l * 16 + (seq - 2)) * 512;
#pragma unroll
            for (int jb = 0; jb < 4; ++jb) { const int ch = n * 64 + jb * 16 + fr; ho[ch] = cblk[jb] * h0[ch] + hblk[jb]; }
        }
    } else {
        float* AGA = (float*)(KWS + WS_AGGA); float* AGH = (float*)(KWS + WS_AGGH);
        if (fq == 0) {
#pragma unroll
            for (int jb = 0; jb < 4; ++jb) { const int ch = n * 64 + jb * 16 + fr;
                __hip_atomic_store(AGA + (size_t)item * 512 + ch, cblk[jb], __ATOMIC_RELAXED, __HIP_MEMORY_SCOPE_AGENT);
                __hip_atomic_store(AGH + (size_t)item * 512 + ch, hblk[jb], __ATOMIC_RELAXED, __HIP_MEMORY_SCOPE_AGENT); }
        }
        asm volatile("s_waitcnt vmcnt(0)" ::: "memory");
        __syncthreads();
        volatile LAS int* qs = (volatile LAS int*)(lds + LDS_MISC_OFF);
        if (tid == 0) { const unsigned old = __hip_atomic_fetch_add(cnt + 64 * seq, 1u, __ATOMIC_RELAXED, __HIP_MEMORY_SCOPE_AGENT); qs[1] = (old == 127u) ? 1 : 0; }
        __syncthreads();
        if (qs[1]) {
            __builtin_amdgcn_fence(__ATOMIC_ACQUIRE, "agent");
            float* CARRY = (float*)(KWS + WS_CARRY) + (size_t)seq * 128 * 512 + tid;
            const float* pa = AGA + (size_t)seq * 128 * 512 + tid; const float* ph = AGH + (size_t)seq * 128 * 512 + tid;
            float h = 0.f;
#pragma unroll 1
            for (int c0 = 0; c0 < 128; c0 += 16) {
                float av[16], hv[16];
#pragma unroll
                for (int c = 0; c < 16; ++c) { av[c] = __hip_atomic_load(pa + (size_t)(c0 + c) * 512, __ATOMIC_RELAXED, __HIP_MEMORY_SCOPE_AGENT); hv[c] = __hip_atomic_load(ph + (size_t)(c0 + c) * 512, __ATOMIC_RELAXED, __HIP_MEMORY_SCOPE_AGENT); }
#pragma unroll
                for (int c = 0; c < 16; ++c) { CARRY[(size_t)(c0 + c) * 512] = h; h = av[c] * h + hv[c]; }
            }
            KOUT[OFF_HP + (size_t)(l * 2 + seq) * 512 + tid] = h;
        }
    }
}

#define ATT_GLD(dst, ptr, OFF) asm volatile("global_load_dwordx4 %0, %1, off offset:" #OFF : "=v"(dst) : "v"(ptr) : "memory")
#define ATT_WAIT(N, K, V) asm volatile("s_waitcnt vmcnt(" #N ")" : "+v"(K[0]), "+v"(K[1]), "+v"(K[2]), "+v"(K[3]), "+v"(V[0]), "+v"(V[1]), "+v"(V[2]), "+v"(V[3]) :: "memory")
__device__ __forceinline__ void attn_item(const Params& P, int l, int item, LAS unsigned char* lds, int wave, int lane_) {
    int lane = lane_; asm volatile("" : "+v"(lane));
    const bf16_t* QKG = (const bf16_t*)(KWS + WS_QKG); const bf16_t* VT = (const bf16_t*)(KWS + WS_VT);
    const bf16_t* KC = (const bf16_t*)(KWS + WS_KC); const bf16_t* VTC = (const bf16_t*)(KWS + WS_VTC);
    bf16_t* AR = (bf16_t*)(KWS + WS_H);
    const LAS float* tab = (const LAS float*)(lds + LDS_TAB_OFF) + wave * LDS_TAB_STRIDE;
    const int sc_ = item >> 1, qh = item & 1;
    const int seq = sc_ < 256 ? (sc_ >> 7) : 2 + (sc_ - 256), chunk = sc_ < 256 ? (sc_ & 127) : 8;
    const int h = wave, i32 = lane & 31, hi = lane >> 5;
    const int rowbase = seq < 2 ? seq * 8192 + chunk * 64 : MP + (seq - 2) * 64;
    const int qrow = rowbase + 32 * qh + i32;
    const int pi = (i32 & 0x13) | ((i32 & 4) << 1) | ((i32 & 8) >> 1);
    bf16x8 bq[4];
#pragma unroll
    for (int ks = 0; ks < 4; ++ks) bq[ks] = *(const GAS bf16x8*)(QKG + (size_t)qrow * NMAIN + h * 64 + 16 * ks + 8 * hi);
    f32x16 o0, o1;
#pragma unroll
    for (int r = 0; r < 16; ++r) { o0[r] = 0.f; o1[r] = 0.f; }
    float mrun = -1e30f, lrun = 0.f;
    const int jstart = (seq < 2 && chunk < 8) ? 2 * (8 - chunk) : 0;
    const int tq = 32 * qh + i32;

    const bf16_t* KFb = (const bf16_t*)(KWS + WS_KF);
    auto issue = [&](int j_, bf16x8 (&KF)[4], bf16x8 (&VF)[4]) {
        const bf16_t* kp; const bf16_t* vp;
        if (seq >= 2 && j_ < 16) { const size_t o = ((size_t)(((seq - 2) * 16 + j_) * 8 + h) * 4) * 512 + lane * 8; kp = KC + o; vp = VTC + o; }
        else { const int tok0 = seq < 2 ? seq * 8192 + 64 * (chunk - 8) + 32 * j_ : MP + (seq - 2) * 64 + 32 * (j_ - 16);
            const size_t o = ((size_t)((tok0 >> 5) * 8 + h) * 4) * 512 + lane * 8; kp = KFb + o; vp = VT + o; }
        ATT_GLD(KF[0], kp, 0); ATT_GLD(KF[1], kp, 1024); ATT_GLD(KF[2], kp, 2048); ATT_GLD(KF[3], kp, 3072);
        ATT_GLD(VF[0], vp, 0); ATT_GLD(VF[1], vp, 1024); ATT_GLD(VF[2], vp, 2048); ATT_GLD(VF[3], vp, 3072);
    };
    auto compute = [&](int j, const bf16x8 (&kf)[4], const bf16x8 (&vf)[4]) {
        f32x16 s;
#pragma unroll
        for (int r = 0; r < 16; ++r) s[r] = 0.f;
#pragma unroll
        for (int ks = 0; ks < 4; ++ks) s = __builtin_amdgcn_mfma_f32_32x32x16_bf16(kf[ks], bq[ks], s, 0, 0, 0);
        float mt = -1e30f;
        if (j < 8) {
            const float bc = tab[512];
#pragma unroll
            for (int r = 0; r < 16; ++r) { s[r] = s[r] * 0.125f + bc; mt = fmaxf(mt, s[r]); }
        } else {
            const LAS float* tp = tab + (768 + tq - 32 * j - 8 * hi);
            float bv[16];
#pragma unroll
            for (int r = 0; r < 16; ++r) bv[r] = tp[-(16 * (r >> 3) + (r & 7))];
#pragma unroll
            for (int r = 0; r < 16; ++r) { s[r] = s[r] * 0.125f + bv[r]; mt = fmaxf(mt, s[r]); }
        }
        mt = fmaxf(mt, __shfl_xor(mt, 32));
        const float mnew = fmaxf(mrun, mt), alpha = __expf(mrun - mnew);
        float ps = 0.f;
#pragma unroll
        for (int r = 0; r < 16; ++r) { s[r] = __expf(s[r] - mnew); ps += s[r]; }
        lrun = lrun * alpha + ps; mrun = mnew;
#pragma unroll
        for (int r = 0; r < 16; ++r) { o0[r] *= alpha; o1[r] *= alpha; }
        u32x4 p0, p1;
        p0.x = cvt_pk_bf16(s[0], s[1]); p0.y = cvt_pk_bf16(s[2], s[3]); p0.z = cvt_pk_bf16(s[4], s[5]); p0.w = cvt_pk_bf16(s[6], s[7]);
        p1.x = cvt_pk_bf16(s[8], s[9]); p1.y = cvt_pk_bf16(s[10], s[11]); p1.z = cvt_pk_bf16(s[12], s[13]); p1.w = cvt_pk_bf16(s[14], s[15]);
        const bf16x8 pb0 = __builtin_bit_cast(bf16x8, p0), pb1 = __builtin_bit_cast(bf16x8, p1);
        o0 = __builtin_amdgcn_mfma_f32_32x32x16_bf16(vf[0], pb0, o0, 0, 0, 0);
        o0 = __builtin_amdgcn_mfma_f32_32x32x16_bf16(vf[1], pb1, o0, 0, 0, 0);
        o1 = __builtin_amdgcn_mfma_f32_32x32x16_bf16(vf[2], pb0, o1, 0, 0, 0);
        o1 = __builtin_amdgcn_mfma_f32_32x32x16_bf16(vf[3], pb1, o1, 0, 0, 0);
    };
    bf16x8 ka[4], va[4], kb[4], vb[4];
    asm volatile("" :: "v"(bq[0]), "v"(bq[1]), "v"(bq[2]), "v"(bq[3]));
    int j = jstart;
    issue(j, ka, va);
#pragma unroll 1
    for (;;) {
        issue(j + 1, kb, vb); ATT_WAIT(8, ka, va);
        compute(j, ka, va);
        ++j;
        issue(j + 1 < 18 ? j + 1 : 17, ka, va); ATT_WAIT(8, kb, vb);
        compute(j, kb, vb);
        ++j;
        if (j >= 18) break;
    }
    ATT_WAIT(0, ka, va);
    const float inv = 1.0f / (lrun + __shfl_xor(lrun, 32));
    bf16_t* orow = AR + (size_t)qrow * DM + h * 64 + 4 * hi;
#pragma unroll
    for (int g = 0; g < 4; ++g) {
        u32x2 w0, w1;
        w0.x = cvt_pk_bf16(o0[4 * g] * inv, o0[4 * g + 1] * inv); w0.y = cvt_pk_bf16(o0[4 * g + 2] * inv, o0[4 * g + 3] * inv);
        w1.x = cvt_pk_bf16(o1[4 * g] * inv, o1[4 * g + 1] * inv); w1.y = cvt_pk_bf16(o1[4 * g + 2] * inv, o1[4 * g + 3] * inv);
        *(u32x2*)(orow + 8 * g) = w0; *(u32x2*)(orow + 32 + 8 * g) = w1;
    }
}

__device__ __forceinline__ void rnn_final_phase(const Params& P, int l, int gtid, int NT) {
    const bf16_t* QKG = (const bf16_t*)(KWS + WS_QKG); const bf16_t* HL = (const bf16_t*)(KWS + WS_HL); const bf16_t* CA = (const bf16_t*)(KWS + WS_CA);
    const float* CARRY = (const float*)(KWS + WS_CARRY); const float* h0 = KIN(7) + (size_t)l * 16 * 512;
    bf16_t* RN = (bf16_t*)(KWS + WS_H) + 512;
#pragma unroll 2
    for (int it = gtid; it < MT * 64; it += NT) {
        const int row = it >> 6, c8 = (it & 63) * 8;
        const float* cp = row < MP ? CARRY + ((size_t)((row >> 13) * 128 + ((row & 8191) >> 6))) * 512 + c8 : h0 + (size_t)((row - MP) >> 6) * 512 + c8;
        const f32x4 ca0 = *(const f32x4*)cp, ca1 = *(const f32x4*)(cp + 4);
        const u32x4 hc0 = *(const u32x4*)((const unsigned*)HL + (size_t)row * 512 + c8), hc1 = *(const u32x4*)((const unsigned*)HL + (size_t)row * 512 + c8 + 4), rg = *(const u32x4*)(QKG + (size_t)row * NMAIN + 1536 + c8);
        float o[8];
#pragma unroll
        for (int e = 0; e < 4; ++e) {
            const float c_lo = e < 2 ? ca0[2 * e] : ca1[2 * e - 4], c_hi = e < 2 ? ca0[2 * e + 1] : ca1[2 * e - 3];
            const unsigned w_lo = e < 2 ? hc0[2 * e] : hc1[2 * e - 4], w_hi = e < 2 ? hc0[2 * e + 1] : hc1[2 * e - 3];
            o[2 * e] = (bflo(w_lo) + bfhi(w_lo) * c_lo) * gelu_tanh(bflo(rg[e]));
            o[2 * e + 1] = (bflo(w_hi) + bfhi(w_hi) * c_hi) * gelu_tanh(bfhi(rg[e]));
        }
        u32x4 w; w.x = cvt_pk_bf16(o[0], o[1]); w.y = cvt_pk_bf16(o[2], o[3]); w.z = cvt_pk_bf16(o[4], o[5]); w.w = cvt_pk_bf16(o[6], o[7]);
        *(u32x4*)(RN + (size_t)row * DM + c8) = w;
    }
}

__device__ __forceinline__ void act_phase(const Params& P, int l, int hf, int gtid, int NT) {
    const bf16_t* UP = (const bf16_t*)(KWS + WS_UP); bf16_t* ACT = (bf16_t*)(KWS + WS_ACT);
    const float* cw = KIN(27) + (size_t)l * 3 * DUP; const float* cbp = KIN(28) + (size_t)l * DUP;
    for (int it = gtid; it < (MT / 16) * (HF / 8); it += NT) {
        const int rc = it / (HF / 8), cg8 = it % (HF / 8), j0 = cg8 * 8, row0 = rc * 16;
        const int gv = hf * HF + j0, gg = DFF + hf * HF + j0;
        float wv[3][8], wg[3][8], bv[8], bg[8];
#pragma unroll
        for (int k = 0; k < 3; ++k)
#pragma unroll
            for (int e = 0; e < 8; ++e) { wv[k][e] = cw[k * DUP + gv + e]; wg[k][e] = cw[k * DUP + gg + e]; }
#pragma unroll
        for (int e = 0; e < 8; ++e) { bv[e] = cbp[gv + e]; bg[e] = cbp[gg + e]; }
        float v0[8], v1[8], g0[8], g1[8];
        const int tseq = row0 < MP ? (row0 & 8191) : ((row0 - MP) & 63);
        if (tseq == 0) {
            if (row0 < MP) {
#pragma unroll
                for (int e = 0; e < 8; ++e) { v0[e] = v1[e] = g0[e] = g1[e] = 0.f; }
            } else {
                const float* st = KIN(8) + ((size_t)(l * 16 + ((row0 - MP) >> 6)) * 2) * DUP;
#pragma unroll
                for (int e = 0; e < 8; ++e) { v0[e] = st[gv + e]; v1[e] = st[DUP + gv + e]; g0[e] = st[gg + e]; g1[e] = st[DUP + gg + e]; }
            }
        } else {
            const u32x4 a0 = *(const u32x4*)(UP + (size_t)(row0 - 2) * HUP + j0), a1 = *(const u32x4*)(UP + (size_t)(row0 - 1) * HUP + j0);
            const u32x4 b0 = *(const u32x4*)(UP + (size_t)(row0 - 2) * HUP + HF + j0), b1 = *(const u32x4*)(UP + (size_t)(row0 - 1) * HUP + HF + j0);
#pragma unroll
            for (int e = 0; e < 4; ++e) { v0[2 * e] = bflo(a0[e]); v0[2 * e + 1] = bfhi(a0[e]); v1[2 * e] = bflo(a1[e]); v1[2 * e + 1] = bfhi(a1[e]);
                g0[2 * e] = bflo(b0[e]); g0[2 * e + 1] = bfhi(b0[e]); g1[2 * e] = bflo(b1[e]); g1[2 * e + 1] = bfhi(b1[e]); }
        }
#pragma unroll 4
        for (int t = 0; t < 16; ++t) {
            const size_t row = row0 + t;
            const u32x4 a2 = *(const u32x4*)(UP + row * HUP + j0), b2 = *(const u32x4*)(UP + row * HUP + HF + j0);
            float v2[8], g2[8], o[8];
#pragma unroll
            for (int e = 0; e < 4; ++e) { v2[2 * e] = bflo(a2[e]); v2[2 * e + 1] = bfhi(a2[e]); g2[2 * e] = bflo(b2[e]); g2[2 * e + 1] = bfhi(b2[e]); }
#pragma unroll
            for (int e = 0; e < 8; ++e) {
                const float val = bv[e] + wv[0][e] * v0[e] + wv[1][e] * v1[e] + wv[2][e] * v2[e];
                const float gt = bg[e] + wg[0][e] * g0[e] + wg[1][e] * g1[e] + wg[2][e] * g2[e];
                o[e] = val * gelu_tanh(gt);
                v0[e] = v1[e]; v1[e] = v2[e]; g0[e] = g1[e]; g1[e] = g2[e];
            }
            u32x4 w; w.x = cvt_pk_bf16(o[0], o[1]); w.y = cvt_pk_bf16(o[2], o[3]); w.z = cvt_pk_bf16(o[4], o[5]); w.w = cvt_pk_bf16(o[6], o[7]);
            *(u32x4*)(ACT + row * DFF + hf * HF + j0) = w;
        }
    }
}


#define XB_TMO      128
#define XB_XCNT(j)  (256  + 64 * (j))
#define XB_XSUB(j)  (1280 + 64 * (j))
#define XB_XGEN(j)  (2304 + 64 * (j))
#define XB_TOP      3328
#define XB_TOPGEN   3392
#define XCD_BAR_WORDS 3456
#define XB_SPIN_CAP (1u << 18)
__device__ __forceinline__ unsigned xb_ld(unsigned* p)              { return __hip_atomic_load(p, __ATOMIC_RELAXED, __HIP_MEMORY_SCOPE_AGENT); }
__device__ __forceinline__ unsigned xb_add(unsigned* p, unsigned v) { return __hip_atomic_fetch_add(p, v, __ATOMIC_RELAXED, __HIP_MEMORY_SCOPE_AGENT); }
__device__ __forceinline__ unsigned xb_xcc_id() { return (unsigned)__builtin_amdgcn_s_getreg((3 << 11) | 20) & 0xFu; }
#define XB_SPIN(cond, bar) do { unsigned _sp = 0; while (cond) { __builtin_amdgcn_s_sleep(1); \
    if ((++_sp & 255u) == 0u) { if (xb_ld(&(bar)[XB_TMO])) break; if (_sp > XB_SPIN_CAP) { atomicAdd(&(bar)[XB_TMO], 1u); break; } } } } while (0)
struct XcdBarrier { unsigned* bar; unsigned x; volatile LAS unsigned* st; int wv; };
__device__ __forceinline__ XcdBarrier xcd_barrier_post(unsigned* bar, volatile LAS unsigned* st, int wv) {
    XcdBarrier b; b.bar = bar; b.x = xb_xcc_id(); b.st = st; b.wv = wv;
    if (wv == 0 && lane_id() == 0) (void)xb_add(&bar[XB_XCNT(b.x)], 1u);
    return b;
}
__device__ __forceinline__ void xcd_barrier_complete(unsigned* bar, unsigned x, unsigned& nloc, unsigned& nx) {
    const unsigned G = gridDim.x * gridDim.y * gridDim.z;
    unsigned sum, cnt, mine, sp = 0u;
    for (;;) {
        sum = 0u; cnt = 0u; mine = 0u;
#pragma unroll
        for (unsigned j = 0; j < 16; ++j) { const unsigned c = xb_ld(&bar[XB_XCNT(j)]); sum += c; cnt += (c > 0u) ? 1u : 0u; mine = (j == x) ? c : mine; }
        if (sum == G) break;
        __builtin_amdgcn_s_sleep(1);
        if ((++sp & 255u) == 0u) { if (xb_ld(&bar[XB_TMO])) break; if (sp > XB_SPIN_CAP) { atomicAdd(&bar[XB_TMO], 1u); break; } }
    }
    nloc = mine > 0u ? mine : 1u; nx = cnt > 0u ? cnt : 1u;
}
template <bool FIRST>
__device__ __forceinline__ void xcd_barrier_t(const XcdBarrier& b) {
    asm volatile("s_waitcnt vmcnt(0)" ::: "memory");
    __syncthreads();
    if (b.wv == 0 && lane_id() == 0) {
        unsigned* bar = b.bar;
        __builtin_amdgcn_s_waitcnt(0);
        unsigned nloc = b.st[0], nx = b.st[1];
        if constexpr (FIRST) { if (nloc == 0u) { xcd_barrier_complete(bar, b.x, nloc, nx); b.st[0] = nloc; b.st[1] = nx; } }
        const unsigned old = xb_add(&bar[XB_XSUB(b.x)], 1u);
        const unsigned gen = old / nloc;
        if (old + 1u == (gen + 1u) * nloc) {
            __builtin_amdgcn_fence(__ATOMIC_RELEASE, "agent");
            asm volatile("s_waitcnt vmcnt(0)" ::: "memory");
            const unsigned og = xb_add(&bar[XB_TOP], 1u);
            const unsigned tg = og / nx;
            if (og + 1u == (tg + 1u) * nx) xb_add(&bar[XB_TOPGEN], 1u);
            else XB_SPIN(xb_ld(&bar[XB_TOPGEN]) == tg, bar);
            __builtin_amdgcn_fence(__ATOMIC_ACQUIRE, "agent");
            xb_add(&bar[XB_XGEN(b.x)], 1u);
            asm volatile("s_waitcnt vmcnt(0)" ::: "memory");
        } else {
            XB_SPIN(xb_ld(&bar[XB_XGEN(b.x)]) == gen, bar);
            __builtin_amdgcn_fence(__ATOMIC_ACQUIRE, "agent");
            asm volatile("s_waitcnt vmcnt(0)" ::: "memory");
        }
    }
    __syncthreads();
}

#ifndef PHMASK
#define PHMASK 0xFFFF
#endif
#define PH(b) if constexpr ((PHMASK >> (b)) & 1)
#ifndef REPMASK
#define REPMASK 0
#endif
#ifndef RNNREP
#define RNNREP 1
#endif
#ifndef ATTREP
#define ATTREP 1
#endif
#ifndef ATT2X
#define ATT2X 1
#endif
#ifndef SYNCREP
#define SYNCREP 1
#endif
#define REPS(b) ((((REPMASK) >> (b)) & 1) ? 2 : 1)
#define RLOOP(b)
#define GSYNC() xcd_barrier_t<false>(xbar)
__global__ void __launch_bounds__(512) fwd_megakernel(Params P) {
    extern __shared__ __attribute__((aligned(16))) unsigned char lds_raw[];
    cg::grid_group grid = cg::this_grid();
    LAS unsigned char* lds = (LAS unsigned char*)lds_raw;
#define THREAD_IDS() const int lane = lane_id(), wave = wave_s, tid = wave_s * 64 + lane; \
    const int gw = blockIdx.x * 8 + wave, gtid = blockIdx.x * 512 + tid; (void)gw; (void)gtid; (void)lane
    const int G = gridDim.x, NGW = G * 8, NT = G * 512;
    unsigned char* ws = KWS;
    unsigned* ctl = (unsigned*)(ws + WS_CTL);
    float* mods = (float*)(ws + WS_MODS);
    float* X = KOUT + OFF_Y;
    bf16_t* Hb = (bf16_t*)(ws + WS_H);

    const int wave_s = __builtin_amdgcn_readfirstlane((int)threadIdx.x >> 6);
    { const int l0_ = lane_id(); if (wave_s == 0 && l0_ < 16) ((LAS unsigned*)(lds + LDS_MISC_OFF))[l0_] = 0u; }
    __syncthreads();
    const XcdBarrier xbar = xcd_barrier_post(ctl + 4096, (volatile LAS unsigned*)(lds + LDS_MISC_OFF + 16), wave_s);
    {
    THREAD_IDS();
    RLOOP(0) mods_phase(P, lds, tid, wave, lane);
    RLOOP(1) convert_layer(P, 0, lds, gw, NGW, wave, lane);
    }
    xcd_barrier_t<true>(xbar);
    if (ws == nullptr) grid.sync();

#pragma unroll 1
    for (int l_ = 0; l_ < 2; ++l_) {
        int l = l_; asm volatile("" : "+s"(l));
        THREAD_IDS();
        unsigned char* ws = KWS; unsigned* ctl = (unsigned*)(ws + WS_CTL); float* mods = (float*)(ws + WS_MODS); float* X = KOUT + OFF_Y; bf16_t* Hb = (bf16_t*)(ws + WS_H);
        if (l == 1) { RLOOP(1) convert_layer(P, 1, lds, gw, NGW, wave, lane); }
        RLOOP(2) { norm_phase(l == 0 ? KIN(0) : X, l == 0 ? KIN(1) : X + (size_t)MP * DM, KIN(11) + l * DM, mods + (size_t)(l * 2 + 0) * 18 * 3072, Hb, l == 0 ? X : nullptr, (const bf16_t*)(ws + WS_QKG), l == 0 ? 0 : 11, gw, NGW, lane);
        GSYNC(); }
        RLOOP(3) {
            pg8::Sched<68, 16, true> S; S.A = (const char*)(ws + WS_H); S.B = (const char*)(ws + WS_WIN);
            S.tstep = (size_t)256 * DM * 2; S.G = G; S.c = blockIdx.x; S.nt = DM / 64;
            EpiG1 E{(bf16_t*)(ws + WS_QKG), (bf16_t*)(ws + WS_VT), (bf16_t*)(ws + WS_KF), KOUT, l};
            pg8::gemm_phase<EpiG1>(lds, DM, S, E, wave_s);
            GSYNC();
        }
        RLOOP(4) {
            const int lane = lane_id(), tid = wave_s * 64 + lane;
            const float* tb = KIN(13) + (size_t)l * 513 * 8;
            for (int i = tid; i < 832 * 8; i += 512) { const int idx = i >> 3, hh = i & 7; ((LAS float*)(lds + LDS_TAB_OFF))[hh * LDS_TAB_STRIDE + idx] = tb[(idx > 512 ? 512 : idx) * 8 + hh]; }
            volatile LAS int* qslot = (volatile LAS int*)(lds + LDS_MISC_OFF);
            int nxt = 0;
            if (tid == 0) nxt = (int)atomicAdd(ctl + 64 * (l + 1), 1u);
            for (;;) {
                __syncthreads();
                if (tid == 0) qslot[0] = nxt;
                __syncthreads();
                const int it = qslot[0];
                if (it >= NITEM_RNN + ATT2X * NITEM_ATT) break;
                if (tid == 0) nxt = (int)atomicAdd(ctl + 64 * (l + 1), 1u);
                if (it < NITEM_RNN) { rnn_item(P, l, it, lds, ctl + 64 * (16 + l * 2), tid, wave, lane); }
                else attn_item(P, l, NITEM_ATT - 1 - (it - NITEM_RNN) % NITEM_ATT, lds, wave, lane);
            }
            GSYNC();
        }
        RLOOP(5) { rnn_final_phase(P, l, blockIdx.x * 512 + wave_s * 64 + lane_id(), NT);
        GSYNC(); }
        RLOOP(6) {
            pg8::SchedPair S; S.A = (const char*)(ws + WS_H); S.B = (const char*)(ws + WS_WBR);
            S.tstep = (size_t)256 * DM * 2; S.G = G; S.c = blockIdx.x;
            EpiBr E{(const bf16_t*)(ws + WS_QKG), (bf16_t*)(ws + WS_MG), (bf16_t*)(ws + WS_VT)};
            pg8::gemm_phase<EpiBr>(lds, DM, S, E, wave_s);
            GSYNC();
        }
        RLOOP(7) {
            pg8::SchedWout S; S.A = (const char*)(ws + WS_MG); S.TS = (const char*)(ws + WS_VT); S.B = (const char*)(ws + WS_WOUT);
            S.tstep = (size_t)256 * DM * 2; S.G = G; S.c = blockIdx.x;
            float* Xo = X;
            EpiRes E{l == 0 ? KIN(0) : X, l == 0 ? KIN(1) : X + (size_t)MP * DM, Xo, mods + (size_t)(l * 2 + 0) * 18 * 3072 + 2048, (bf16_t*)(ws + WS_QKG)};
            pg8::gemm_phase<EpiRes>(lds, DM, S, E, wave_s);
            GSYNC();
        }
        RLOOP(2) { norm_phase(X, X + (size_t)MP * DM, KIN(25) + l * DM, mods + (size_t)(l * 2 + 1) * 18 * 3072, Hb, nullptr, (const bf16_t*)(ws + WS_QKG), 16, gw, NGW, lane_id());
        GSYNC(); }
        RLOOP(8) {
            pg8::Sched<68, 22, false> S; S.A = (const char*)(ws + WS_H); S.B = (const char*)(ws + WS_WUP);
            S.tstep = (size_t)256 * DM * 2; S.G = G; S.c = blockIdx.x; S.nt = DM / 64;
            EpiUpAct E{(bf16_t*)(ws + WS_ACT), KOUT, (float*)(ws + WS_HEAD), (float*)(ws + WS_TAIL), KIN(27) + (size_t)l * 3 * DUP, KIN(28) + (size_t)l * DUP, KIN(8), (LAS float*)(lds + LDS_TAB_OFF), l};
            pg8::gemm_phase<EpiUpAct>(lds, DM, S, E, wave_s);
            GSYNC();
        }
        RLOOP(10) {
            pg8::SchedSplit<11> S; S.A = (const char*)(ws + WS_ACT); S.B = (const char*)(ws + WS_WDN);
            S.tstep = (size_t)256 * DFF * 2; S.G = G; S.c = blockIdx.x; S.K = DFF;
            { pg8::Unit u0; if (S.next(0, u0) && u0.kind == 0 && (u0.pm & 31) != 0) ffn_fix_tile(P, l, u0.pm, wave_s * 64 + lane_id());
              asm volatile("s_waitcnt vmcnt(0)" ::: "memory"); __syncthreads(); }
            float* Xo = X;
            EpiRes E{X, X + (size_t)MP * DM, Xo, mods + (size_t)(l * 2 + 1) * 18 * 3072 + 2048, (bf16_t*)(ws + WS_QKG)};
            pg8::gemm_phase<EpiRes>(lds, DFF, S, E, wave_s);
            GSYNC();
        }
    }
    {
        THREAD_IDS();
        const float* g = KIN(30);
        for (int row = gw; row < MT; row += NGW) {
            float* xr = X + (size_t)row * DM;
            f32x4 v[4]; float s = 0.f;
#pragma unroll
            for (int j = 0; j < 4; ++j) {
                v[j] = *(const f32x4*)(xr + 4 * lane + 256 * j);
                if (row >= MP) { const bf16_t* pp = (const bf16_t*)(ws + WS_QKG) + (size_t)(row - MP) * DM + 4 * lane + 256 * j;
                    for (int sl = 0; sl < 11; ++sl) { const u32x2 w = *(const u32x2*)(pp + (size_t)sl * 1024 * DM); v[j][0] += bflo(w.x); v[j][1] += bfhi(w.x); v[j][2] += bflo(w.y); v[j][3] += bfhi(w.y); } }
                s += (v[j][0] * v[j][0] + v[j][1] * v[j][1]) + (v[j][2] * v[j][2] + v[j][3] * v[j][3]);
            }
            const float rstd = rsqrtf(wave_sum(s) * (1.0f / DM) + 1e-6f);
#pragma unroll
            for (int j = 0; j < 4; ++j) { const int c = 4 * lane + 256 * j; *(f32x4*)(xr + c) = v[j] * rstd * *(const f32x4*)(g + c); }
        }
    }
}

extern "C" void kernel_launch(void* const* d_in, const int* in_sizes, int n_in, void* d_out, int out_size, void* d_ws, size_t ws_size, hipStream_t stream) {
    static int grid = 0;
    if (grid == 0) {
        if (n_in != 31 || ws_size < WS_NEED) { fprintf(stderr, "kernel_launch: unexpected n_in %d / ws %zu\n", n_in, ws_size); grid = -1; return; }
        int dev = 0, cus = 0, per_cu = 0;
        (void)hipGetDevice(&dev);
        (void)hipDeviceGetAttribute(&cus, hipDeviceAttributeMultiprocessorCount, dev);
        if (hipFuncSetAttribute((const void*)fwd_megakernel, hipFuncAttributeMaxDynamicSharedMemorySize, LDS_BYTES) != hipSuccess) { fprintf(stderr, "kernel_launch: hipFuncSetAttribute failed\n"); grid = -1; return; }
        if (hipOccupancyMaxActiveBlocksPerMultiprocessor(&per_cu, (const void*)fwd_megakernel, 512, LDS_BYTES) != hipSuccess || per_cu < 1) { fprintf(stderr, "kernel_launch: occupancy query gave %d\n", per_cu); grid = -1; return; }
        grid = cus;
    }
    if (grid < 0) return;
    (void)hipMemsetAsync((char*)d_ws + WS_CTL, 0, 65536, stream);
    Params p{};
    for (int i = 0; i < 31; ++i) p.in[i] = (const float*)d_in[i];
    p.out = (float*)d_out; p.ws = (unsigned char*)d_ws;
    void* args[] = {&p};
    hipError_t e = hipLaunchCooperativeKernel((void*)fwd_megakernel, dim3(grid), dim3(512), args, LDS_BYTES, stream);
    if (e != hipSuccess) fprintf(stderr, "cooperative launch failed: %s (grid %d)\n", hipGetErrorString(e), grid);
}
```

```cpp
#include <hip/hip_runtime.h>
#include <hip/hip_cooperative_groups.h>
#include <cstdio>
#include <cstdint>
namespace cg = cooperative_groups;

#define LAS __attribute__((address_space(3)))
#define GAS __attribute__((address_space(1)))
typedef unsigned short bf16_t;
typedef short bf16x8 __attribute__((ext_vector_type(8)));
typedef float f32x4 __attribute__((ext_vector_type(4)));
typedef float f32x2 __attribute__((ext_vector_type(2)));
typedef float f32x16 __attribute__((ext_vector_type(16)));
typedef unsigned u32x4 __attribute__((ext_vector_type(4)));
typedef unsigned u32x2 __attribute__((ext_vector_type(2)));

constexpr int MT = 17408, MP = 16384, DM = 1024, NMAIN = 4096, DIN = 4608, DFF = 2816, DUP = 5632, HUP = 2816  , HF = 1408;
constexpr int NITEM_RNN = 272, NITEM_ATT = 544;
constexpr size_t OFF_Y = 0, OFF_KP = 17825792, OFF_VP = 18874368, OFF_KS = 19922944, OFF_VS = 20971520, OFF_RCP = 22020096, OFF_RCS = 22026240,
                 OFF_HP = 22075392, OFF_HS = 22077440, OFF_FCP = 22093824, OFF_FCS = 22138880;
constexpr size_t MiB = 1u << 20;
constexpr size_t WS_CTL = 0;
constexpr size_t WS_MODS = 64 * 1024;
constexpr size_t WS_AGGA = 1 * MiB, WS_AGGH = 2 * MiB;
constexpr size_t WS_WG = 3 * MiB;
constexpr size_t WS_CARRY = 3 * MiB + 256 * 1024;
constexpr size_t WS_WIN = 4 * MiB, WS_WBR = 13 * MiB, WS_WOUT = 15 * MiB, WS_WUP = 17 * MiB, WS_WDN = 28 * MiB;
constexpr size_t WS_KC = 34 * MiB, WS_VTC = 42 * MiB;
constexpr size_t WS_HEAD = 34 * MiB, WS_TAIL = 38 * MiB;
constexpr size_t WS_H = 50 * MiB;
constexpr size_t WS_QKG = 84 * MiB;
constexpr size_t WS_VT = 220 * MiB;
constexpr size_t WS_HL = 237 * MiB, WS_CA = 254 * MiB;
constexpr size_t WS_MG = 237 * MiB;
constexpr size_t WS_UP = 84 * MiB;
constexpr size_t WS_ACT = 178 * MiB;
constexpr size_t WS_KF = 272 * MiB;
constexpr size_t WS_NEED = 290 * MiB;
constexpr int LDS_XC_STRIDE = 516;
constexpr int LDS_TAB_OFF = 64 * LDS_XC_STRIDE * 4;
constexpr int LDS_TAB_STRIDE = 832;
constexpr int LDS_MISC_OFF = LDS_TAB_OFF + 8 * LDS_TAB_STRIDE * 4;
constexpr int LDS_BYTES = LDS_MISC_OFF + 64;

struct Params { const float* in[31]; float* out; unsigned char* ws; };


template <int OFF> __device__ __forceinline__ unsigned long long karg_u64() {
    auto ka = __builtin_amdgcn_kernarg_segment_ptr();
    unsigned long long v; asm volatile("s_load_dwordx2 %0, %1, %2\n\ts_waitcnt lgkmcnt(0)" : "=s"(v) : "s"(ka), "n"(OFF)); return v;
}
#define KIN(i) ((const float*)karg_u64<8 * (i)>())
#define KOUT ((float*)karg_u64<248>())
#define KWS ((unsigned char*)karg_u64<256>())
__device__ __forceinline__ unsigned cvt_pk_bf16(float lo, float hi) { unsigned r; asm volatile("v_cvt_pk_bf16_f32 %0, %1, %2" : "=v"(r) : "v"(lo), "v"(hi)); return r; }
__device__ __forceinline__ float bf2f(unsigned short b) { return __uint_as_float((unsigned)b << 16); }
__device__ __forceinline__ float bflo(unsigned w) { return __uint_as_float(w << 16); }
__device__ __forceinline__ float bfhi(unsigned w) { return __uint_as_float(w & 0xffff0000u); }
__device__ __forceinline__ float sigmoidf_(float x) { return __builtin_amdgcn_rcpf(1.0f + __expf(-x)); }
__device__ __forceinline__ float gelu_tanh(float x) { const float z = 1.5957691216057308f * (x + 0.044715f * x * x * x); return x * __builtin_amdgcn_rcpf(1.0f + __expf(-z)); }
__device__ __forceinline__ float wave_sum(float v) {
#pragma unroll
    for (int o = 1; o < 64; o <<= 1) v += __shfl_xor(v, o);
    return v;
}
#define LDS_WAIT() asm volatile("s_waitcnt lgkmcnt(0)" ::: "memory")
__device__ __forceinline__ int lane_id() { int r; asm volatile("v_mbcnt_lo_u32_b32 %0, -1, 0\n\tv_mbcnt_hi_u32_b32 %0, -1, %0" : "=v"(r)); return r; }

namespace pg8 {
constexpr int BM = 256, BK = 64, HALF = 128, HTB = HALF * BK * 2, STAGE_BYTES = 8 * HTB;
__device__ __forceinline__ int lds_byte(int r, int c) { const int st = (r >> 4) * 2 + (c >> 5), rr = r & 15, cc = c & 31, ob = rr * 64 + cc * 2; return st * 1024 + (ob ^ (((ob >> 9) & 1) << 5)); }
__device__ __forceinline__ void stage_rc(int b, int& R, int& C) { const int st = b / 1024, sb = b % 1024, swz = sb ^ (((sb >> 9) & 1) << 5); R = (st >> 1) * 16 + swz / 64; C = (st & 1) * 32 + (swz % 64) / 2; }
__device__ __forceinline__ int perm32(int rho) { const int n = rho >> 4, i = rho & 15; return 8 * (i >> 2) + 4 * n + (i & 3); }

struct Unit { int pm, pn, kind, nt; };

template <int nM, int nN, bool VT>
struct Sched {
    const char* A; const char* B; size_t tstep; int G, c, nt;
    static constexpr int nwg = nM * nN;
    __device__ __forceinline__ bool next(int i, Unit& u) const {
        const int L = i * G + c;
        int pm = 0, pn = 0, kind = 0; bool ok = true;
        if (L < nwg) {
            int wgid = L; { constexpr int q = nwg / 8, r = nwg % 8; const int xcd = wgid % 8, off = wgid / 8; wgid = (xcd < r ? xcd * (q + 1) : r * (q + 1) + (xcd - r) * q) + off; }
            constexpr int nig = 8 * nN; const int gid = wgid / nig, fm = gid * 8, gsz = (nM - fm) < 8 ? (nM - fm) : 8;
            pm = fm + ((wgid % nig) % gsz); pn = (wgid % nig) / gsz;
        } else {
            const int e = L - nwg;
            if (VT && e < 136) { kind = 1; pm = e & 1; pn = e >> 1; } else ok = false;
        }
        u.pm = pm; u.pn = pn; u.kind = kind; u.nt = nt;
        return ok;
    }
    __device__ __forceinline__ const char* abase(const Unit& u) const { if constexpr (VT) { if (u.kind) return B + (size_t)(16 + u.pm) * tstep; } return A + (size_t)u.pm * tstep; }
    __device__ __forceinline__ const char* bbase(const Unit& u) const { if constexpr (VT) { if (u.kind) return A + (size_t)u.pn * tstep; } return B + (size_t)u.pn * tstep; }
};
template <int NSL>
struct SchedSplit {
    const char* A; const char* B; size_t tstep; int G, c, K;
    __device__ __forceinline__ bool next(int i, Unit& u) const {
        const int L = i * G + c;
        int pm, pn, kind, ntl; bool ok = true;
        if (L < 256) {
            const int wgid = (L % 8) * 32 + L / 8, gid = wgid / 32;
            pm = gid * 8 + ((wgid % 32) % 8); pn = (wgid % 32) / 8; kind = 0; ntl = K / 64;
        } else {
            const int e = L - 256, un = e / NSL, sl = e % NSL;
            ok = e < 16 * NSL;
            pm = 64 + ((un >> 2) & 3); pn = (un & 3) | (sl << 8); kind = 1; ntl = K / NSL / 64;
        }
        u.pm = pm; u.pn = pn; u.kind = kind; u.nt = ntl;
        return ok;
    }
    __device__ __forceinline__ const char* abase(const Unit& u) const { return A + (size_t)u.pm * tstep + (size_t)(u.pn >> 8) * (K / NSL) * 2; }
    __device__ __forceinline__ const char* bbase(const Unit& u) const { return B + (size_t)(u.pn & 255) * tstep + (size_t)(u.pn >> 8) * (K / NSL) * 2; }
};

struct SchedPair {
    const char* A; const char* B; size_t tstep; int G, c;
    __device__ __forceinline__ bool next(int i, Unit& u) const {
        int pm, pn, kind, ntl; bool ok = true;
        if (i == 0) {
            const int wgid = (c % 8) * 32 + c / 8, gid = wgid / 32;
            pm = gid * 8 + ((wgid % 32) % 8); pn = (wgid % 32) / 8; kind = 0; ntl = 16; ok = c < 256;
        } else {
            const int e = (i - 1) * G + c, un = e >> 2, q = e & 3;
            ok = e < 64;
            pm = 64 + ((un >> 2) & 3); pn = (un & 3) | (q << 8); kind = 2; ntl = 4;
        }
        u.pm = pm; u.pn = pn; u.kind = kind; u.nt = ntl;
        return ok;
    }
    __device__ __forceinline__ const char* abase(const Unit& u) const { return A + (size_t)u.pm * tstep + (size_t)(u.pn >> 8) * 512; }
    __device__ __forceinline__ const char* bbase(const Unit& u) const { return B + (size_t)(u.pn & 255) * tstep + (size_t)(u.pn >> 8) * 512; }
};

struct SchedWout {
    const char* A; const char* TS; const char* B; size_t tstep; int G, c;
    __device__ __forceinline__ bool next(int i, Unit& u) const {
        const int L = i * G + c;
        int pm, pn, kind, ntl; bool ok = true;
        if (L < 256) {
            const int wgid = (L % 8) * 32 + L / 8, gid = wgid / 32;
            pm = gid * 8 + ((wgid % 32) % 8); pn = (wgid % 32) / 8; kind = 0; ntl = 16;
        } else {
            const int e = L - 256, un = e >> 3, r = e & 7;
            ok = e < 128;
            pm = 64 + ((un >> 2) & 3); pn = (un & 3) | (r << 8); kind = 1; ntl = 8;
        }
        u.pm = pm; u.pn = pn; u.kind = kind; u.nt = ntl;
        return ok;
    }
    __device__ __forceinline__ const char* abase(const Unit& u) const { const int r = u.pn >> 8; return u.kind ? TS + (size_t)(r >> 1) * (1024 * 1024 * 2) + (size_t)(u.pm - 64) * tstep + (size_t)(r & 1) * 1024 : A + (size_t)u.pm * tstep; }
    __device__ __forceinline__ const char* bbase(const Unit& u) const { return B + (size_t)(u.pn & 255) * tstep + (size_t)((u.pn >> 8) & 1) * 1024; }
};

template <class Epi, class SchedT>
__device__ __forceinline__ void gemm_phase(LAS unsigned char* lds, const int K, const SchedT& S, const Epi& E, const int wv) {
    const int tid_ = wv * 64 + lane_id();
    const int tid = tid_, wid = __builtin_amdgcn_readfirstlane(tid >> 6), lane = tid & 63, wr = wid >> 2, wc = wid & 3, fr = lane & 15, fq = lane >> 4;
    unsigned voffA0, voffA1, voffB0, voffB1;
    { int R, C; stage_rc(tid * 16, R, C); const int Rb = Epi::PERM ? ((R & ~31) + perm32(R & 31)) : R; voffA0 = (unsigned)(R * K + C) * 2u; voffB0 = (unsigned)(Rb * K + C) * 2u; }
    { int R, C; stage_rc(tid * 16 + 8192, R, C); const int Rb = Epi::PERM ? ((R & ~31) + perm32(R & 31)) : R; voffA1 = (unsigned)(R * K + C) * 2u; voffB1 = (unsigned)(Rb * K + C) * 2u; }
    const size_t kstep = (size_t)(BK * 2);
    const size_t hstep = (size_t)HALF * K * 2;
    const unsigned ldsw = (unsigned)wid * 1024u;
    const int aoff = lds_byte(wr * 64 + fr, fq * 8), boff = lds_byte(wc * 32 + fr, fq * 8);
#define PG8_SA(b, h) (((b) * 2 + (h)) * HTB)
#define PG8_SB(b, h) ((4 + (b) * 2 + (h)) * HTB)
#define PG8_STAGE(bufoff, gbase, voff) do { \
        __builtin_amdgcn_global_load_lds((const unsigned*)((const char*)(gbase) + voff##0), (LAS unsigned*)(lds + (bufoff) + ldsw), 16, 0, 0); \
        __builtin_amdgcn_global_load_lds((const unsigned*)((const char*)(gbase) + voff##1), (LAS unsigned*)(lds + (bufoff) + ldsw + 8192), 16, 0, 0); } while (0)
#define PG8_LDA(dst, b, h) do { _Pragma("unroll") for (int m = 0; m < 4; ++m) _Pragma("unroll") for (int k = 0; k < 2; ++k) dst[m][k] = *(const LAS bf16x8*)(lds + PG8_SA(b, h) + aoff + m * 2048 + k * 1024); } while (0)
#define PG8_LDB(dst, b, h) do { _Pragma("unroll") for (int n = 0; n < 2; ++n) _Pragma("unroll") for (int k = 0; k < 2; ++k) dst[n][k] = *(const LAS bf16x8*)(lds + PG8_SB(b, h) + boff + n * 2048 + k * 1024); } while (0)
#define PG8_MMA(ai, bj, At, Bt) do { __builtin_amdgcn_s_setprio(1); _Pragma("unroll") for (int m = 0; m < 4; ++m) _Pragma("unroll") for (int n = 0; n < 2; ++n) _Pragma("unroll") for (int k = 0; k < 2; ++k) \
        acc[ai][bj][m][n] = __builtin_amdgcn_mfma_f32_16x16x32_bf16(Bt[n][k], At[m][k], acc[ai][bj][m][n], 0, 0, 0); __builtin_amdgcn_s_setprio(0); } while (0)
#define PG8_WAIT_V(n) asm volatile("s_waitcnt vmcnt(" #n ")" ::: "memory")
#define PG8_WAIT_L(n) asm volatile("s_waitcnt lgkmcnt(" #n ")" ::: "memory")
#define PG8_BAR __builtin_amdgcn_s_barrier()
#define PG8_SCHED __builtin_amdgcn_sched_barrier(0)
    Unit cur, nxt; int ui = 0;
    if (!S.next(0, cur)) return;
    f32x4 acc[2][2][4][2];
#pragma unroll
    for (int a = 0; a < 2; ++a)
#pragma unroll
        for (int b = 0; b < 2; ++b)
#pragma unroll
            for (int m = 0; m < 4; ++m)
#pragma unroll
                for (int n = 0; n < 2; ++n) acc[a][b][m][n] = (f32x4){0.f, 0.f, 0.f, 0.f};
    bf16x8 At[4][2], B0[2][2], B1[2][2];
    const char* cA = S.abase(cur); const char* cB = S.bbase(cur);
    PG8_STAGE(PG8_SB(0, 0), cB, voffB); PG8_STAGE(PG8_SB(0, 1), cB + hstep, voffB); PG8_STAGE(PG8_SA(0, 0), cA, voffA); PG8_STAGE(PG8_SA(0, 1), cA + hstep, voffA);
    if (wr == 1) PG8_BAR;
    PG8_WAIT_V(2); PG8_BAR;
    PG8_STAGE(PG8_SB(1, 0), cB + kstep, voffB); PG8_STAGE(PG8_SA(1, 0), cA + kstep, voffA); PG8_STAGE(PG8_SB(1, 1), cB + hstep + kstep, voffB);
    PG8_WAIT_V(6); PG8_BAR;
    for (;;) {
        const bool has_next = S.next(ui + 1, nxt);
        const char* nA = has_next ? S.abase(nxt) : cA; const char* nB = has_next ? S.bbase(nxt) : cB;
        const int nt = cur.nt;
        for (int t = 0; t < nt; t += 2) {
            if constexpr (Epi::HAS_MID) { if (t == 8 && cur.kind == 0) E.mid(acc, cur, wr, wc, fr, fq); }
            const bool last = (t == nt - 2);
            const char* a1 = cA + (size_t)(t + 1) * kstep;
            const char* a2 = last ? nA : cA + (size_t)(t + 2) * kstep; const char* b2 = last ? nB : cB + (size_t)(t + 2) * kstep;
            const char* a3 = a2 + kstep; const char* b3 = b2 + kstep;
            PG8_LDB(B0, 0, 0); PG8_LDB(B1, 0, 1); PG8_SCHED; PG8_LDA(At, 0, 0); PG8_STAGE(PG8_SA(1, 1), a1 + hstep, voffA);
            PG8_WAIT_V(8); PG8_WAIT_L(0); PG8_BAR; PG8_MMA(0, 0, At, B0); PG8_MMA(0, 1, At, B1); PG8_BAR; PG8_SCHED;
            PG8_LDA(At, 0, 1); PG8_STAGE(PG8_SB(0, 0), b2, voffB); PG8_STAGE(PG8_SB(0, 1), b2 + hstep, voffB); PG8_STAGE(PG8_SA(0, 0), a2, voffA);
            PG8_WAIT_V(8); PG8_WAIT_L(0); PG8_BAR; PG8_MMA(1, 0, At, B0); PG8_MMA(1, 1, At, B1); PG8_BAR; PG8_SCHED;
            PG8_LDB(B0, 1, 0); PG8_LDB(B1, 1, 1); PG8_SCHED; PG8_LDA(At, 1, 0); PG8_STAGE(PG8_SA(0, 1), a2 + hstep, voffA);
            PG8_WAIT_V(8); PG8_WAIT_L(0); PG8_BAR; PG8_MMA(0, 0, At, B0); PG8_MMA(0, 1, At, B1); PG8_BAR; PG8_SCHED;
            PG8_LDA(At, 1, 1); PG8_STAGE(PG8_SB(1, 0), b3, voffB); PG8_STAGE(PG8_SB(1, 1), b3 + hstep, voffB); PG8_STAGE(PG8_SA(1, 0), a3, voffA);
            PG8_WAIT_V(8); PG8_WAIT_L(0); PG8_BAR; PG8_MMA(1, 0, At, B0); PG8_MMA(1, 1, At, B1); PG8_BAR; PG8_SCHED;
        }
        if (wr == 0) PG8_BAR;
        E(acc, cur, wr, wc, fr, fq);
        if (!has_next) break;
#pragma unroll
        for (int a = 0; a < 2; ++a)
#pragma unroll
            for (int b = 0; b < 2; ++b)
#pragma unroll
                for (int m = 0; m < 4; ++m)
#pragma unroll
                    for (int n = 0; n < 2; ++n) acc[a][b][m][n] = (f32x4){0.f, 0.f, 0.f, 0.f};
        cur = nxt; cA = nA; cB = nB; ++ui;
        if (wr == 1) PG8_BAR;
    }
    PG8_WAIT_V(0);
    PG8_BAR;
#undef PG8_SA
#undef PG8_SB
#undef PG8_STAGE
#undef PG8_LDA
#undef PG8_LDB
#undef PG8_MMA
#undef PG8_WAIT_V
#undef PG8_WAIT_L
#undef PG8_BAR
#undef PG8_SCHED
}
}
using pg8::Unit;

#define EPI_FENCE() asm volatile("" ::: "memory")
__device__ __forceinline__ u32x4 pack8(const f32x4 v0, const f32x4 v1) { u32x4 w; w.x = cvt_pk_bf16(v0[0], v0[1]); w.y = cvt_pk_bf16(v0[2], v0[3]); w.z = cvt_pk_bf16(v1[0], v1[1]); w.w = cvt_pk_bf16(v1[2], v1[3]); return w; }

struct EpiG1 {
    static constexpr bool PERM = true, HAS_MID = false;
    bf16_t* QKG; bf16_t* VT; bf16_t* KF; float* out; int l;
    __device__ __forceinline__ void operator()(const f32x4 (&acc)[2][2][4][2], const Unit& u, int wr, int wc, int fr, int fq) const {
        const int pm = u.pm, pn = u.pn;
        if (u.kind == 0) {
            const bool isK = (pn == 2 || pn == 3), isRx = (pn == 4 || pn == 5);
#pragma unroll
            for (int ai = 0; ai < 2; ++ai)
#pragma unroll
                for (int m = 0; m < 4; ++m) {
                    const int lrow = ai * 128 + wr * 64 + m * 16 + fr, row = pm * 256 + lrow;
#pragma unroll
                    for (int bj = 0; bj < 2; ++bj) {
                        const int c0 = pn * 256 + bj * 128 + wc * 32 + 8 * fq;
                        const f32x4 v0 = acc[ai][bj][m][0], v1 = acc[ai][bj][m][1];
                        if (isK) { const int hcol = c0 - 512, hh = hcol >> 6, d0 = hcol & 63, g = row >> 5, i = row & 31, slot = (i & 0x13) | ((i & 4) << 1) | ((i & 8) >> 1);
                            *(u32x4*)(KF + ((size_t)((g * 8 + hh) * 4 + (d0 >> 4))) * 512 + (((d0 >> 3) & 1) * 32 + slot) * 8) = pack8(v0, v1); }
                        else *(u32x4*)(QKG + (size_t)row * NMAIN + c0) = pack8(v0, v1);
                        if (isK) {
                            float* dst = nullptr;
                            if (pm < 64) { const int tl = pm & 31; if (tl >= 30) dst = out + OFF_KP + ((size_t)((l * 2 + (pm >> 5)) * 512 + (tl - 30) * 256 + lrow)) * 512 + (c0 - 512); }
                            else dst = out + OFF_KS + ((size_t)(l * 1024 + row - MP)) * 512 + (c0 - 512);
                            if (dst) { *(f32x4*)dst = v0; *(f32x4*)(dst + 4) = v1; }
                        }
                        if (isRx) {
                            float* dst = nullptr;
                            if (pm < 64) { if ((pm & 31) == 31 && lrow >= 253) dst = out + OFF_RCP + ((size_t)((l * 2 + (pm >> 5)) * 3 + (lrow - 253))) * 512 + (c0 - 1024); }
                            else { const int s = row - MP, t = s & 63; if (t >= 61) dst = out + OFF_RCS + ((size_t)((l * 16 + (s >> 6)) * 3 + (t - 61))) * 512 + (c0 - 1024); }
                            if (dst) { *(f32x4*)dst = v0; *(f32x4*)(dst + 4) = v1; }
                        }
                    }
                }
        } else {
            const bool qual = (pn >= 64) || ((pn & 31) >= 30);
#pragma unroll
            for (int ai = 0; ai < 2; ++ai)
#pragma unroll
                for (int m = 0; m < 4; ++m) {
                    const int hd = pm * 256 + ai * 128 + wr * 64 + m * 16 + fr;
#pragma unroll
                    for (int bj = 0; bj < 2; ++bj) {
                        const int t0 = pn * 256 + bj * 128 + wc * 32 + 8 * fq;
                        const f32x4 v0 = acc[ai][bj][m][0], v1 = acc[ai][bj][m][1];
                        { const int hh = hd >> 6, d = hd & 63, g = t0 >> 5;
                          *(u32x4*)(VT + ((size_t)((g * 8 + hh) * 4 + (d >> 5) * 2 + ((t0 >> 4) & 1))) * 512 + (((t0 >> 3) & 1) * 32 + (d & 31)) * 8) = pack8(v0, v1); }
                        if (qual) {
                            float* dst;
                            if (pn < 64) dst = out + OFF_VP + ((size_t)((l * 2 + (pn >> 5)) * 512 + ((t0 & 8191) - 7680))) * 512 + hd;
                            else dst = out + OFF_VS + ((size_t)(l * 1024 + t0 - MP)) * 512 + hd;
                            dst[0] = v0[0]; dst[512] = v0[1]; dst[1024] = v0[2]; dst[1536] = v0[3];
                            dst[2048] = v1[0]; dst[2560] = v1[1]; dst[3072] = v1[2]; dst[3584] = v1[3];
                        }
                    }
                }
        }
    }
};

struct EpiBr {
    static constexpr bool PERM = true, HAS_MID = true;
    const bf16_t* QKG; bf16_t* MG; bf16_t* TS;
    __device__ __forceinline__ void mid(f32x4 (&acc)[2][2][4][2], const Unit& u, int wr, int wc, int fr, int fq) const {
        const bf16_t* gbase = QKG + (size_t)(u.pm * 256 + wr * 64 + fr) * NMAIN + 2048 + u.pn * 256 + wc * 32 + 8 * fq;
        { unsigned long long g_ = (unsigned long long)gbase; asm volatile("" : "+v"(g_)); gbase = (const bf16_t*)g_; }
#pragma unroll
        for (int ai = 0; ai < 2; ++ai)
#pragma unroll
            for (int m = 0; m < 4; ++m) {
#pragma unroll
                for (int bj = 0; bj < 2; ++bj) {
                    const bf16_t* gp = gbase + (size_t)(ai * 128 + m * 16) * NMAIN + bj * 128;
                    const u32x4 ga = *(const GAS u32x4*)gp, gb = *(const GAS u32x4*)(gp + 1024);
#pragma unroll
                    for (int e = 0; e < 4; ++e) {
                        const float r0 = (1.0f + __expf(-fmaxf(bflo(gb[e]), -60.f))) * __builtin_amdgcn_rcpf(1.0f + __expf(-bflo(ga[e])));
                        const float r1 = (1.0f + __expf(-fmaxf(bfhi(gb[e]), -60.f))) * __builtin_amdgcn_rcpf(1.0f + __expf(-bfhi(ga[e])));
                        acc[ai][bj][m][e >> 1][(e & 1) * 2] *= r0; acc[ai][bj][m][e >> 1][(e & 1) * 2 + 1] *= r1;
                    }
                }
                EPI_FENCE();
            }
    }
    __device__ __forceinline__ void operator()(const f32x4 (&acc)[2][2][4][2], const Unit& u, int wr, int wc, int fr, int fq) const {
        const int q = u.pn >> 8, pnn = u.pn & 255;
        const int goff = (u.kind == 2 && (q >> 1) == 0) ? 2048 : 3072;
#pragma unroll
        for (int ai = 0; ai < 2; ++ai)
#pragma unroll
            for (int m = 0; m < 4; ++m) {
                const int row = u.pm * 256 + ai * 128 + wr * 64 + m * 16 + fr;
#pragma unroll
                for (int bj = 0; bj < 2; ++bj) {
                    const int c0 = pnn * 256 + bj * 128 + wc * 32 + 8 * fq;
                    const u32x4 gb = *(const u32x4*)(QKG + (size_t)row * NMAIN + goff + c0);
                    f32x4 v0 = acc[ai][bj][m][0], v1 = acc[ai][bj][m][1];
                    v0[0] *= sigmoidf_(fmaxf(bflo(gb[0]), -60.f)); v0[1] *= sigmoidf_(fmaxf(bfhi(gb[0]), -60.f)); v0[2] *= sigmoidf_(fmaxf(bflo(gb[1]), -60.f)); v0[3] *= sigmoidf_(fmaxf(bfhi(gb[1]), -60.f));
                    v1[0] *= sigmoidf_(fmaxf(bflo(gb[2]), -60.f)); v1[1] *= sigmoidf_(fmaxf(bfhi(gb[2]), -60.f)); v1[2] *= sigmoidf_(fmaxf(bflo(gb[3]), -60.f)); v1[3] *= sigmoidf_(fmaxf(bfhi(gb[3]), -60.f));
                    bf16_t* dst = u.kind == 2 ? TS + (size_t)q * 1024 * 1024 + (size_t)(row - MP) * DM + c0 : MG + (size_t)row * DM + c0;
                    *(u32x4*)dst = pack8(v0, v1);
                }
                EPI_FENCE();
            }
    }
};

struct EpiRes {
    static constexpr bool PERM = false, HAS_MID = false;
    const float* base_p; const float* base_s; float* X; const float* gate; bf16_t* part;
    __device__ __forceinline__ void operator()(const f32x4 (&acc)[2][2][4][2], const Unit& u, int wr, int wc, int fr, int fq) const {
        const int col0 = (u.pn & 255) * 256 + wc * 32 + 4 * fq;
#pragma unroll
        for (int ai = 0; ai < 2; ++ai)
#pragma unroll
            for (int m = 0; m < 4; ++m) {
                const int row = u.pm * 256 + ai * 128 + wr * 64 + m * 16 + fr;
                const int cb = row < MP ? (row >> 13) : 2 + ((row - MP) >> 6);
                const float* bp = row < MP ? base_p + (size_t)row * DM : base_s + (size_t)(row - MP) * DM;
                const float* gp = gate + cb * 3072;
#pragma unroll
                for (int bj = 0; bj < 2; ++bj)
#pragma unroll
                    for (int n = 0; n < 2; ++n) {
                        const int col = col0 + bj * 128 + n * 16;
                        const f32x4 g4 = *(const f32x4*)(gp + col);
                        float* xo = X + (size_t)row * DM + col;
                        if (u.kind) { const f32x4 v = g4 * acc[ai][bj][m][n]; u32x2 w; w.x = cvt_pk_bf16(v[0], v[1]); w.y = cvt_pk_bf16(v[2], v[3]);
                            *(u32x2*)(part + ((size_t)((u.pn >> 8) * 1024 + (row - MP))) * DM + col) = w; }
                        else { const f32x4 b4 = *(const f32x4*)(bp + col); *(f32x4*)xo = b4 + g4 * acc[ai][bj][m][n]; }
                    }
                EPI_FENCE();
            }
    }
};

__device__ __forceinline__ float dpp_ror1(float v) { return __builtin_bit_cast(float, __builtin_amdgcn_update_dpp(0, __builtin_bit_cast(int, v), 0x121, 0xf, 0xf, false)); }
__device__ __forceinline__ float dpp_shr1(float old, float v) { return __builtin_bit_cast(float, __builtin_amdgcn_update_dpp(__builtin_bit_cast(int, old), __builtin_bit_cast(int, v), 0x111, 0xf, 0xf, false)); }
__device__ __forceinline__ float dpp_shr2(float old, float v) { return __builtin_bit_cast(float, __builtin_amdgcn_update_dpp(__builtin_bit_cast(int, old), __builtin_bit_cast(int, v), 0x112, 0xf, 0xf, false)); }
__device__ __forceinline__ float dpp_ror2(float v) { return __builtin_bit_cast(float, __builtin_amdgcn_update_dpp(0, __builtin_bit_cast(int, v), 0x122, 0xf, 0xf, false)); }
struct EpiUpAct {
    static constexpr bool PERM = true, HAS_MID = false;
    bf16_t* ACT; float* out; float* HEAD; float* TAIL; const float* cw; const float* cb; const float* st; LAS float* hal; int l;
    __device__ __forceinline__ void operator()(const f32x4 (&acc)[2][2][4][2], const Unit& u, int wr, int wc, int fr, int fq) const {
        const int pm = u.pm, pn = u.pn;
        const int cl = wc * 32 + 8 * fq;
        const int jb = pn * 128 + cl;
        const bool samp = pm >= 64;
        if (fr >= 14) {
            const int rs = fr - 14;
#pragma unroll
            for (int ai = 0; ai < 2; ++ai) {
                float* fdst = nullptr;
                if (samp) fdst = out + OFF_FCS + ((size_t)((l * 16 + (pm - 64) * 4 + ai * 2 + wr) * 2 + rs)) * DUP;
                else if ((pm & 31) == 31 && ai == 1 && wr == 1) fdst = out + OFF_FCP + ((size_t)((l * 2 + (pm >> 5)) * 2 + rs)) * DUP;
                float* tdst = (!samp && ai == 1 && wr == 1) ? TAIL + ((size_t)(pm * 2 + rs)) * DUP : nullptr;
#pragma unroll
                for (int bj = 0; bj < 2; ++bj)
#pragma unroll
                    for (int n = 0; n < 2; ++n) {
                        const f32x4 v = acc[ai][bj][3][n];
                        *(LAS f32x4*)(hal + ((((ai * 2 + wr) * 2 + rs) * 2 + bj) * 128 + cl + 4 * n)) = v;
                        const int g = bj * DFF + jb + 4 * n;
                        if (fdst) *(f32x4*)(fdst + g) = v;
                        if (tdst) *(f32x4*)(tdst + g) = v;
                    }
            }
        }
        if (fr < 2 && !samp && wr == 0) {
            float* hdst = HEAD + ((size_t)(pm * 2 + fr)) * DUP;
#pragma unroll
            for (int bj = 0; bj < 2; ++bj)
#pragma unroll
                for (int n = 0; n < 2; ++n) *(f32x4*)(hdst + bj * DFF + jb + 4 * n) = acc[0][bj][0][n];
        }
        asm volatile("s_waitcnt lgkmcnt(0)" ::: "memory"); __builtin_amdgcn_s_barrier(); asm volatile("" ::: "memory");
#pragma unroll
        for (int n = 0; n < 2; ++n) {
            const int j0 = jb + 4 * n;
            const f32x4 wv0 = *(const f32x4*)(cw + j0), wv1 = *(const f32x4*)(cw + DUP + j0), wv2 = *(const f32x4*)(cw + 2 * DUP + j0), bv = *(const f32x4*)(cb + j0);
            const f32x4 wg0 = *(const f32x4*)(cw + DFF + j0), wg1 = *(const f32x4*)(cw + DUP + DFF + j0), wg2 = *(const f32x4*)(cw + 2 * DUP + DFF + j0), bg = *(const f32x4*)(cb + DFF + j0);
#pragma unroll
            for (int ai = 0; ai < 2; ++ai) {
                f32x4 h1v, h2v, h1g, h2g;
                if (samp) {
                    const float* sp = st + ((size_t)((l * 16 + (pm - 64) * 4 + ai * 2 + wr) * 2)) * DUP + j0;
                    h2v = *(const f32x4*)sp; h1v = *(const f32x4*)(sp + DUP); h2g = *(const f32x4*)(sp + DFF); h1g = *(const f32x4*)(sp + DUP + DFF);
                } else if (ai == 0 && wr == 0) {
                    h1v = h2v = h1g = h2g = (f32x4){0.f, 0.f, 0.f, 0.f};
                } else {
                    const int sb = (wr == 1) ? (ai * 2) : ((ai - 1) * 2 + 1);
                    const LAS float* hp = hal + (sb * 2 * 2 * 128 + cl + 4 * n);
                    h2v = *(const LAS f32x4*)(hp); h2g = *(const LAS f32x4*)(hp + 128); h1v = *(const LAS f32x4*)(hp + 256); h1g = *(const LAS f32x4*)(hp + 384);
                }
#pragma unroll
                for (int m = 0; m < 4; ++m) {
                    const f32x4 cv = acc[ai][0][m][n], cg = acc[ai][1][m][n];
                    float o[4];
#pragma unroll
                    for (int e = 0; e < 4; ++e) {
                        float p1v, p2v, p1g, p2g;
                        if (m > 0) {
                            const int mp = m > 0 ? m - 1 : 0;
                            p1v = dpp_shr1(dpp_ror1(acc[ai][0][mp][n][e]), cv[e]); p2v = dpp_shr2(dpp_ror2(acc[ai][0][mp][n][e]), cv[e]);
                            p1g = dpp_shr1(dpp_ror1(acc[ai][1][mp][n][e]), cg[e]); p2g = dpp_shr2(dpp_ror2(acc[ai][1][mp][n][e]), cg[e]);
                        } else {
                            p1v = dpp_shr1(h1v[e], cv[e]); p2v = dpp_shr2(fr == 0 ? h2v[e] : h1v[e], cv[e]);
                            p1g = dpp_shr1(h1g[e], cg[e]); p2g = dpp_shr2(fr == 0 ? h2g[e] : h1g[e], cg[e]);
                        }
                        const float val = bv[e] + wv0[e] * p2v + wv1[e] * p1v + wv2[e] * cv[e];
                        const float gt = bg[e] + wg0[e] * p2g + wg1[e] * p1g + wg2[e] * cg[e];
                        o[e] = val * gelu_tanh(gt);
                    }
                    const int row = pm * 256 + ai * 128 + wr * 64 + m * 16 + fr;
                    u32x2 w; w.x = cvt_pk_bf16(o[0], o[1]); w.y = cvt_pk_bf16(o[2], o[3]);
                    *(u32x2*)(ACT + (size_t)row * DFF + j0) = w;
                }
            }
        }
    }
};

__device__ __forceinline__ void ffn_fix_tile(const Params& P, int l, int pm, int tid) {
    const float* HEAD = (const float*)(KWS + WS_HEAD); const float* TAIL = (const float*)(KWS + WS_TAIL); bf16_t* ACT = (bf16_t*)(KWS + WS_ACT);
    const float* cw = KIN(27) + (size_t)l * 3 * DUP; const float* cb = KIN(28) + (size_t)l * DUP;
    for (int it = tid; it < DFF / 4; it += 512) {
        const int j0 = it * 4;
        const float* t0 = TAIL + ((size_t)((pm - 1) * 2)) * DUP + j0; const float* h0 = HEAD + ((size_t)(pm * 2)) * DUP + j0;
        const f32x4 tv0 = *(const f32x4*)t0, tv1 = *(const f32x4*)(t0 + DUP), tg0 = *(const f32x4*)(t0 + DFF), tg1 = *(const f32x4*)(t0 + DUP + DFF);
        const f32x4 hv0 = *(const f32x4*)h0, hv1 = *(const f32x4*)(h0 + DUP), hg0 = *(const f32x4*)(h0 + DFF), hg1 = *(const f32x4*)(h0 + DUP + DFF);
        const f32x4 wv0 = *(const f32x4*)(cw + j0), wv1 = *(const f32x4*)(cw + DUP + j0), wv2 = *(const f32x4*)(cw + 2 * DUP + j0), bv = *(const f32x4*)(cb + j0);
        const f32x4 wg0 = *(const f32x4*)(cw + DFF + j0), wg1 = *(const f32x4*)(cw + DUP + DFF + j0), wg2 = *(const f32x4*)(cw + 2 * DUP + DFF + j0), bg = *(const f32x4*)(cb + DFF + j0);
        const f32x4 v0 = bv + wv0 * tv0 + wv1 * tv1 + wv2 * hv0, g0 = bg + wg0 * tg0 + wg1 * tg1 + wg2 * hg0;
        const f32x4 v1 = bv + wv0 * tv1 + wv1 * hv0 + wv2 * hv1, g1 = bg + wg0 * tg1 + wg1 * hg0 + wg2 * hg1;
        u32x2 w0, w1;
        w0.x = cvt_pk_bf16(v0[0] * gelu_tanh(g0[0]), v0[1] * gelu_tanh(g0[1])); w0.y = cvt_pk_bf16(v0[2] * gelu_tanh(g0[2]), v0[3] * gelu_tanh(g0[3]));
        w1.x = cvt_pk_bf16(v1[0] * gelu_tanh(g1[0]), v1[1] * gelu_tanh(g1[1])); w1.y = cvt_pk_bf16(v1[2] * gelu_tanh(g1[2]), v1[3] * gelu_tanh(g1[3]));
        *(u32x2*)(ACT + (size_t)(pm * 256) * DFF + j0) = w0; *(u32x2*)(ACT + (size_t)(pm * 256 + 1) * DFF + j0) = w1;
    }
}

template <class RowMap>
__device__ __forceinline__ void transpose_item(const float* W, int K, int N, bf16_t* WT, const RowMap& rm, LAS float* scr, int item, int lane) {
    const int nblk = N / 32, kb = item / nblk, nb = item % nblk, k0 = 64 * kb, n0 = 32 * nb;
#pragma unroll
    for (int i = 0; i < 32; ++i) { const int kk = 2 * i + (lane >> 5); scr[kk * 33 + (lane & 31)] = W[(size_t)(k0 + kk) * N + n0 + (lane & 31)]; }
    LDS_WAIT(); asm volatile("" ::: "memory");
    const int c = lane & 7;
    const int d0 = rm(n0);
#pragma unroll
    for (int j = 0; j < 4; ++j) { const int n = (lane >> 3) + 8 * j; const LAS float* s = scr + (8 * c) * 33 + n;
        u32x4 o; o.x = cvt_pk_bf16(s[0 * 33], s[1 * 33]); o.y = cvt_pk_bf16(s[2 * 33], s[3 * 33]); o.z = cvt_pk_bf16(s[4 * 33], s[5 * 33]); o.w = cvt_pk_bf16(s[6 * 33], s[7 * 33]);
        *(u32x4*)(WT + (size_t)(d0 + n) * K + k0 + 8 * c) = o; }
    LDS_WAIT(); asm volatile("" ::: "memory");
}
template <class RowMap>
__device__ __forceinline__ void transpose_block(const float* W, int K, int N, bf16_t* WT, const RowMap& rm, LAS float* tile, int item, int tid) {
    const int nblk = N >> 7, kb = item / nblk, nb = item % nblk, k0 = kb << 7, n0 = nb << 7;
    const int rr = tid >> 5, c4 = (tid & 31) * 4;
    f32x4 v[8];
#pragma unroll
    for (int i = 0; i < 8; ++i) v[i] = __builtin_nontemporal_load((const GAS f32x4*)(W + (size_t)(k0 + rr + 16 * i) * N + n0 + c4));
    __syncthreads();
#pragma unroll
    for (int i = 0; i < 8; ++i) { LAS float* d = tile + (rr + 16 * i) * 129 + c4; d[0] = v[i][0]; d[1] = v[i][1]; d[2] = v[i][2]; d[3] = v[i][3]; }
    __syncthreads();
    const int d0 = rm(n0), c = tid & 15;
#pragma unroll
    for (int p = 0; p < 4; ++p) {
        const int n = (tid >> 4) + 32 * p; const LAS float* sp = tile + (8 * c) * 129 + n;
        u32x4 o; o.x = cvt_pk_bf16(sp[0], sp[129]); o.y = cvt_pk_bf16(sp[2 * 129], sp[3 * 129]); o.z = cvt_pk_bf16(sp[4 * 129], sp[5 * 129]); o.w = cvt_pk_bf16(sp[6 * 129], sp[7 * 129]);
        *(GAS u32x4*)(WT + (size_t)(d0 + n) * K + k0 + 8 * c) = o;
    }
}
struct MapId { __device__ __forceinline__ int operator()(int n0) const { return n0; } };
struct MapWin { __device__ __forceinline__ int operator()(int n0) const { return n0 < 1024 ? n0 : (n0 < 1536 ? 4096 + (n0 - 1024) : n0 - 512); } };
struct MapWup { __device__ __forceinline__ int operator()(int n0) const { const int gate = n0 >= DFF, j = n0 - gate * DFF; return 256 * (j >> 7) + 128 * gate + (j & 127); } };

__device__ __forceinline__ void convert_layer(const Params& P, int l, LAS unsigned char* lds, int gw, int NGW, int wave, int lane) {
    unsigned char* ws = KWS;
    {
        constexpr int I_IN = 8 * 36, I_BR = 8 * 8, I_OUT = 8 * 8, I_UP = 8 * 44, I_DN = 22 * 8;
        constexpr int NIT = I_IN + I_BR + I_OUT + I_UP + I_DN;
        LAS float* tile = (LAS float*)lds;
        const int tid = wave * 64 + lane;
        for (int it = blockIdx.x; it < NIT; it += gridDim.x) {
            int r = it;
            if (r < I_IN) { transpose_block(KIN(12) + (size_t)l * DM * DIN, DM, DIN, (bf16_t*)(ws + WS_WIN), MapWin(), tile, r, tid); continue; } r -= I_IN;
            if (r < I_BR) { transpose_block(KIN(21) + (size_t)l * DM * DM, DM, DM, (bf16_t*)(ws + WS_WBR), MapId(), tile, r, tid); continue; } r -= I_BR;
            if (r < I_OUT) { transpose_block(KIN(22) + (size_t)l * DM * DM, DM, DM, (bf16_t*)(ws + WS_WOUT), MapId(), tile, r, tid); continue; } r -= I_OUT;
            if (r < I_UP) { transpose_block(KIN(26) + (size_t)l * DM * DUP, DM, DUP, (bf16_t*)(ws + WS_WUP), MapWup(), tile, r, tid); continue; } r -= I_UP;
            transpose_block(KIN(29) + (size_t)l * DFF * DM, DFF, DM, (bf16_t*)(ws + WS_WDN), MapId(), tile, r, tid);
        }
        __syncthreads();
    }
    const float* wga_ = KIN(16); const float* wgx_ = KIN(18);
    for (int i = gw * 64 + lane; i < 8 * 2 * 4 * 2 * 64; i += NGW * 64) {
        const int ln = i & 63, ks = (i >> 6) & 1, jb = (i >> 7) & 3, gsel = (i >> 9) & 1, n = i >> 10, fr = ln & 15, fq = ln >> 4;
        const float* wg = (gsel ? wgx_ : wga_) + ((size_t)(l * 8 + n)) * 64 * 64;
        float f[8];
#pragma unroll
        for (int e = 0; e < 8; ++e) f[e] = wg[(ks * 32 + fq * 8 + e) * 64 + jb * 16 + fr];
        u32x4 w; w.x = cvt_pk_bf16(f[0], f[1]); w.y = cvt_pk_bf16(f[2], f[3]); w.z = cvt_pk_bf16(f[4], f[5]); w.w = cvt_pk_bf16(f[6], f[7]);
        *(u32x4*)(ws + WS_WG + (size_t)i * 16) = w;
    }
    const float* ck = KIN(4) + (size_t)l * 16 * 512 * 512; bf16_t* kc = (bf16_t*)(ws + WS_KC);
    const float* cv = KIN(5) + (size_t)l * 16 * 512 * 512; bf16_t* vc = (bf16_t*)(ws + WS_VTC);
    const int gt = gw * 64 + lane, NGT = NGW * 64;
#pragma unroll 2
    for (int i = gt; i < 16 * 16 * 8 * 4 * 64; i += NGT) {
        const int ln = i & 63, ks = (i >> 6) & 3, hh = (i >> 8) & 7, tile = (i >> 11) & 15, b = i >> 15;
        const int sl = ln & 31, r = tile * 32 + ((sl & 0x13) | ((sl & 4) << 1) | ((sl & 8) >> 1));
        const float* p = ck + ((size_t)(b * 512 + r)) * 512 + hh * 64 + ks * 16 + (ln >> 5) * 8;
        *(u32x4*)(kc + (size_t)i * 8) = pack8(__builtin_nontemporal_load((const f32x4*)p), __builtin_nontemporal_load((const f32x4*)(p + 4)));
    }
#pragma unroll 2
    for (int i = gt; i < 16 * 16 * 8 * 4 * 64; i += NGT) {
        const int ln = i & 63, q = (i >> 6) & 3, hh = (i >> 8) & 7, tile = (i >> 11) & 15, b = i >> 15;
        const int d = 32 * (q >> 1) + (ln & 31), r0 = tile * 32 + 16 * (q & 1) + 8 * (ln >> 5);
        const float* p = cv + ((size_t)(b * 512 + r0)) * 512 + hh * 64 + d;
        u32x4 w; w.x = cvt_pk_bf16(__builtin_nontemporal_load(p), __builtin_nontemporal_load(p + 512)); w.y = cvt_pk_bf16(__builtin_nontemporal_load(p + 1024), __builtin_nontemporal_load(p + 1536));
        w.z = cvt_pk_bf16(__builtin_nontemporal_load(p + 2048), __builtin_nontemporal_load(p + 2560)); w.w = cvt_pk_bf16(__builtin_nontemporal_load(p + 3072), __builtin_nontemporal_load(p + 3584));
        *(u32x4*)(vc + (size_t)i * 8) = w;
    }
}

__device__ __forceinline__ void mods_phase(const Params& P, LAS unsigned char* lds, int tid, int wave, int lane) {
    LAS float* sT = (LAS float*)lds;
    LAS float* red = (LAS float*)(lds + 81920);
    float* mods = (float*)(KWS + WS_MODS);
    for (int it = blockIdx.x; it < 192; it += gridDim.x) {
        const int lk = it / 48, cbk = it % 48, l = lk >> 1, kind = lk & 1, col0 = cbk * 64;
        const float* W = (kind ? KIN(23) : KIN(9)) + (size_t)l * DM * 3072;
        const float* bias = (kind ? KIN(24) : KIN(10)) + (size_t)l * 3072;
        __syncthreads();
        const float* cp_ = KIN(2); const float* cs_ = KIN(3);
        for (int i = tid; i < 18 * 1024; i += 512) { const int r = i >> 10, k = i & 1023; const float c = r < 2 ? cp_[r * 1024 + k] : cs_[(r - 2) * 1024 + k]; sT[k * 20 + r] = c * __builtin_amdgcn_rcpf(1.0f + __expf(-c)); }
        __syncthreads();
        float acc[18];
#pragma unroll
        for (int r = 0; r < 18; ++r) acc[r] = 0.f;
        const int kb = wave * 128;
#pragma unroll 16
        for (int k = 0; k < 128; ++k) {
            const float w = __builtin_nontemporal_load(W + (size_t)(kb + k) * 3072 + col0 + lane);
            const LAS f32x4* sp = (const LAS f32x4*)(sT + (kb + k) * 20);
            const f32x4 s0 = sp[0], s1 = sp[1], s2 = sp[2], s3 = sp[3]; const f32x2 s4 = *(const LAS f32x2*)(sT + (kb + k) * 20 + 16);
            acc[0] += s0[0] * w; acc[1] += s0[1] * w; acc[2] += s0[2] * w; acc[3] += s0[3] * w;
            acc[4] += s1[0] * w; acc[5] += s1[1] * w; acc[6] += s1[2] * w; acc[7] += s1[3] * w;
            acc[8] += s2[0] * w; acc[9] += s2[1] * w; acc[10] += s2[2] * w; acc[11] += s2[3] * w;
            acc[12] += s3[0] * w; acc[13] += s3[1] * w; acc[14] += s3[2] * w; acc[15] += s3[3] * w;
            acc[16] += s4[0] * w; acc[17] += s4[1] * w;
        }
#pragma unroll
        for (int r = 0; r < 18; ++r) red[(wave * 18 + r) * 64 + lane] = acc[r];
        __syncthreads();
        for (int o = tid; o < 18 * 64; o += 512) {
            const int r = o >> 6, cl = o & 63; float s = bias[col0 + cl];
#pragma unroll
            for (int w = 0; w < 8; ++w) s += red[(w * 18 + r) * 64 + cl];
            mods[((size_t)lk * 18 + r) * 3072 + col0 + cl] = s;
        }
    }
    __syncthreads();
}

__device__ __forceinline__ void norm_phase(const float* xp, const float* xs, const float* g, const float* mod  , bf16_t* H, float* xcopy  , const bf16_t* part, int nsl  , int gw, int NGW, int lane_) {
    int lane = lane_; asm volatile("" : "+v"(lane));
    auto rowptr = [&](int row) { return row < MP ? xp + (size_t)row * DM : xs + (size_t)(row - MP) * DM; };
    auto finish = [&](int row, f32x4 (&v)[4]) {
        const float* xr = rowptr(row);
        const int cb = row < MP ? (row >> 13) : 2 + ((row - MP) >> 6);
        const float* sh = mod + cb * 3072; const float* sc = sh + 1024;
        if (nsl > 0 && row >= MP) {
#pragma unroll
            for (int j = 0; j < 4; ++j) {
                const bf16_t* pp = part + (size_t)(row - MP) * DM + 4 * lane + 256 * j;
                for (int sl = 0; sl < nsl; ++sl) { const u32x2 w = *(const u32x2*)(pp + (size_t)sl * 1024 * DM); v[j][0] += bflo(w.x); v[j][1] += bfhi(w.x); v[j][2] += bflo(w.y); v[j][3] += bfhi(w.y); }
                *(f32x4*)((float*)xr + 4 * lane + 256 * j) = v[j];
            }
        }
        if (xcopy && row >= MP) {
#pragma unroll
            for (int j = 0; j < 4; ++j) *(f32x4*)(xcopy + (size_t)row * DM + 4 * lane + 256 * j) = v[j];
        }
        float s = 0.f;
#pragma unroll
        for (int j = 0; j < 4; ++j) s += (v[j][0] * v[j][0] + v[j][1] * v[j][1]) + (v[j][2] * v[j][2] + v[j][3] * v[j][3]);
        const float rstd = rsqrtf(wave_sum(s) * (1.0f / DM) + 1e-6f);
#pragma unroll
        for (int j = 0; j < 4; ++j) {
            const int c = 4 * lane + 256 * j;
            const f32x4 g4 = *(const f32x4*)(g + c), s4 = *(const f32x4*)(sh + c), c4 = *(const f32x4*)(sc + c);
            const f32x4 o = (v[j] * rstd * g4) * (c4 + 1.0f) + s4;
            u32x2 w; w.x = cvt_pk_bf16(o[0], o[1]); w.y = cvt_pk_bf16(o[2], o[3]);
            *(u32x2*)(H + (size_t)row * DM + c) = w;
        }
    };
    int row = gw;
    for (; row + NGW < MT; row += 2 * NGW) {
        const float* xa = rowptr(row); const float* xb = rowptr(row + NGW);
        f32x4 va[4], vb[4];
#pragma unroll
        for (int j = 0; j < 4; ++j) { va[j] = __builtin_nontemporal_load((const f32x4*)(xa + 4 * lane + 256 * j)); vb[j] = __builtin_nontemporal_load((const f32x4*)(xb + 4 * lane + 256 * j)); }
        finish(row, va); finish(row + NGW, vb);
    }
    if (row < MT) {
        const float* xa = rowptr(row);
        f32x4 va[4];
#pragma unroll
        for (int j = 0; j < 4; ++j) va[j] = __builtin_nontemporal_load((const f32x4*)(xa + 4 * lane + 256 * j));
        finish(row, va);
    }
}

__device__ __forceinline__ void rnn_item(const Params& P, int l, int item, LAS unsigned char* lds, unsigned* cnt, int tid_, int wave, int lane_) {
    int tid = tid_, lane = lane_; asm volatile("" : "+v"(tid), "+v"(lane));
    LAS float* xc = (LAS float*)lds;
    const bf16_t* QKG = (const bf16_t*)(KWS + WS_QKG);
    bf16_t* HL = (bf16_t*)(KWS + WS_HL); bf16_t* CA = (bf16_t*)(KWS + WS_CA);
    const int seq = item < 256 ? (item >> 7) : 2 + (item - 256), chunk = item < 256 ? (item & 127) : 0;
    const int rowbase = seq < 2 ? seq * 8192 + chunk * 64 : MP + (seq - 2) * 64;
    LDS_WAIT(); asm volatile("" ::: "memory");
    {
        const int ch = tid;
        const float* cw = KIN(14) + (size_t)l * 4 * 512; const float w0 = cw[ch], w1 = cw[512 + ch], w2 = cw[1024 + ch], w3 = cw[1536 + ch], cbias = KIN(15)[l * 512 + ch];
        float x0, x1, x2;
        if (seq < 2) {
            if (chunk == 0) { x0 = x1 = x2 = 0.f; }
            else { const bf16_t* p = QKG + (size_t)(rowbase - 3) * NMAIN + 1024 + ch; x0 = bf2f(p[0]); x1 = bf2f(p[NMAIN]); x2 = bf2f(p[2 * NMAIN]); }
        } else { const float* st = KIN(6) + ((size_t)(l * 16 + (seq - 2)) * 3) * 512 + ch; x0 = st[0]; x1 = st[512]; x2 = st[1024]; }
        {
            const int rr = lane >> 3, cc = lane & 7;
            const bf16_t* p = QKG + (size_t)(rowbase + rr) * NMAIN + 1024 + wave * 64 + cc * 8;
            u32x4 raw[8];
#pragma unroll
            for (int i = 0; i < 8; ++i) raw[i] = *(const GAS u32x4*)(p + (size_t)(8 * i) * NMAIN);
#pragma unroll
            for (int i = 0; i < 8; ++i) {
                LAS float* d = xc + (8 * i + rr) * LDS_XC_STRIDE + wave * 64 + cc * 8;
                *(LAS f32x4*)d = (f32x4){bflo(raw[i][0]), bfhi(raw[i][0]), bflo(raw[i][1]), bfhi(raw[i][1])};
                *(LAS f32x4*)(d + 4) = (f32x4){bflo(raw[i][2]), bfhi(raw[i][2]), bflo(raw[i][3]), bfhi(raw[i][3])};
            }
        }
        LDS_WAIT(); asm volatile("" ::: "memory");
        {
            LAS float* col = xc + ch;
            float r3 = col[63 * LDS_XC_STRIDE], r2 = col[62 * LDS_XC_STRIDE], r1 = col[61 * LDS_XC_STRIDE];
#pragma unroll 8
            for (int t = 63; t >= 0; --t) {
                const float r0 = t >= 3 ? col[(t - 3) * LDS_XC_STRIDE] : (t == 2 ? x2 : (t == 1 ? x1 : x0));
                col[t * LDS_XC_STRIDE] = cbias + w0 * r0 + w1 * r1 + w2 * r2 + w3 * r3;
                r3 = r2; r2 = r1; r1 = r0;
            }
        }
    }
    LDS_WAIT(); asm volatile("" ::: "memory");
    const int n = wave, fr = lane & 15, fq = lane >> 4;
    bf16x8 Bw[2][4][2];
    const unsigned char* wgp_ = KWS + WS_WG;
#pragma unroll
    for (int gsel = 0; gsel < 2; ++gsel)
#pragma unroll
        for (int jb = 0; jb < 4; ++jb)
#pragma unroll
            for (int ks = 0; ks < 2; ++ks) Bw[gsel][jb][ks] = *(const bf16x8*)(wgp_ + ((size_t)((((n * 2 + gsel) * 4 + jb) * 2 + ks) * 64 + lane)) * 16);
    float ba[4], bx[4], spl[4];
    const float* bap_ = KIN(17) + l * 512; const float* bxp_ = KIN(19) + l * 512; const float* lmp_ = KIN(20) + l * 512;
#pragma unroll
    for (int jb = 0; jb < 4; ++jb) { const int ch = n * 64 + jb * 16 + fr; ba[jb] = bap_[ch]; bx[jb] = bxp_[ch];
        const float lam = lmp_[ch]; spl[jb] = -8.0f * (lam > 15.f ? __expf(-lam) : log1pf(__expf(-lam))); }
    float hblk[4] = {0.f, 0.f, 0.f, 0.f}, cblk[4] = {1.f, 1.f, 1.f, 1.f};
#pragma unroll 1
    for (int tb = 0; tb < 4; ++tb) {
        bf16x8 Af[2];
#pragma unroll
        for (int ks = 0; ks < 2; ++ks) {
            const LAS float* xp = xc + (tb * 16 + fr) * LDS_XC_STRIDE + n * 64 + ks * 32 + fq * 8;
            const f32x4 a = *(const LAS f32x4*)xp, b = *(const LAS f32x4*)(xp + 4);
            const u32x4 w = pack8(a, b); Af[ks] = __builtin_bit_cast(bf16x8, w);
        }
#pragma unroll
        for (int jb = 0; jb < 4; ++jb) {
            f32x4 ga = {0.f, 0.f, 0.f, 0.f}, gx = {0.f, 0.f, 0.f, 0.f};
#pragma unroll
            for (int ks = 0; ks < 2; ++ks) { ga = __builtin_amdgcn_mfma_f32_16x16x32_bf16(Af[ks], Bw[0][jb][ks], ga, 0, 0, 0); gx = __builtin_amdgcn_mfma_f32_16x16x32_bf16(Af[ks], Bw[1][jb][ks], gx, 0, 0, 0); }
            const int ch = n * 64 + jb * 16 + fr;
            float a[4], uu[4];
#pragma unroll
            for (int r = 0; r < 4; ++r) {
                const int t = tb * 16 + fq * 4 + r;
                const float xv = xc[t * LDS_XC_STRIDE + ch];
                const float rr = sigmoidf_(ga[r] + ba[jb]), ig = sigmoidf_(gx[r] + bx[jb]);
                const float la = spl[jb] * rr;
                a[r] = __expf(la);
                const float y = -2.0f * la;
                const float om = y < 0.25f ? y * (1.0f + y * (-0.5f + y * (0.16666667f + y * (-0.041666668f + y * 0.0083333338f)))) : 1.0f - a[r] * a[r];
                uu[r] = __builtin_amdgcn_sqrtf(fmaxf(om, 0.f)) * (ig * xv);
            }
            float A4 = a[0], U4 = uu[0];
#pragma unroll
            for (int r = 1; r < 4; ++r) { U4 = a[r] * U4 + uu[r]; A4 *= a[r]; }
            float Ai = A4, Ui = U4;
            { const float Ap = __shfl_up(Ai, 16), Up = __shfl_up(Ui, 16); if (fq >= 1) { Ui = Ai * Up + Ui; Ai = Ap * Ai; } }
            { const float Ap = __shfl_up(Ai, 32), Up = __shfl_up(Ui, 32); if (fq >= 2) { Ui = Ai * Up + Ui; Ai = Ap * Ai; } }
            float Ae = __shfl_up(Ai, 16), Ue = __shfl_up(Ui, 16); if (fq == 0) { Ae = 1.f; Ue = 0.f; }
            const float Atot = __shfl(Ai, 48 + fr), Utot = __shfl(Ui, 48 + fr);
            float h = Ae * hblk[jb] + Ue, c = cblk[jb] * Ae;
#pragma unroll
            for (int r = 0; r < 4; ++r) {
                h = a[r] * h + uu[r]; c *= a[r];
                const size_t o = (size_t)(rowbase + tb * 16 + fq * 4 + r) * 512 + ch;
                ((unsigned*)HL)[o] = cvt_pk_bf16(h, c);
            }
            hblk[jb] = Atot * hblk[jb] + Utot; cblk[jb] *= Atot;
        }
    }
    if (seq >= 2) {
        if (fq == 0) {
            const float* h0 = KIN(7) + (size_t)(l * 16 + (seq - 2)) * 512; float* ho = KOUT + OFF_HS + (size_t)(l * 16 + (seq - 2)) * 512;
#pragma unroll
            for (int jb = 0; jb < 4; ++jb) { const int ch = n * 64 + jb * 16 + fr; ho[ch] = cblk[jb] * h0[ch] + hblk[jb]; }
        }
    } else {
        float* AGA = (float*)(KWS + WS_AGGA); float* AGH = (float*)(KWS + WS_AGGH);
        if (fq == 0) {
#pragma unroll
            for (int jb = 0; jb < 4; ++jb) { const int ch = n * 64 + jb * 16 + fr;
                __hip_atomic_store(AGA + (size_t)item * 512 + ch, cblk[jb], __ATOMIC_RELAXED, __HIP_MEMORY_SCOPE_AGENT);
                __hip_atomic_store(AGH + (size_t)item * 512 + ch, hblk[jb], __ATOMIC_RELAXED, __HIP_MEMORY_SCOPE_AGENT); }
        }
        asm volatile("s_waitcnt vmcnt(0)" ::: "memory");
        __syncthreads();
        volatile LAS int* qs = (volatile LAS int*)(lds + LDS_MISC_OFF);
        if (tid == 0) { const unsigned old = __hip_atomic_fetch_add(cnt + 64 * seq, 1u, __ATOMIC_RELAXED, __HIP_MEMORY_SCOPE_AGENT); qs[1] = (old == 127u) ? 1 : 0; }
        __syncthreads();
        if (qs[1]) {
            __builtin_amdgcn_fence(__ATOMIC_ACQUIRE, "agent");
            float* CARRY = (float*)(KWS + WS_CARRY) + (size_t)seq * 128 * 512 + tid;
            const float* pa = AGA + (size_t)seq * 128 * 512 + tid; const float* ph = AGH + (size_t)seq * 128 * 512 + tid;
            float h = 0.f;
#pragma unroll 1
            for (int c0 = 0; c0 < 128; c0 += 16) {
                float av[16], hv[16];
#pragma unroll
                for (int c = 0; c < 16; ++c) { av[c] = __hip_atomic_load(pa + (size_t)(c0 + c) * 512, __ATOMIC_RELAXED, __HIP_MEMORY_SCOPE_AGENT); hv[c] = __hip_atomic_load(ph + (size_t)(c0 + c) * 512, __ATOMIC_RELAXED, __HIP_MEMORY_SCOPE_AGENT); }
#pragma unroll
                for (int c = 0; c < 16; ++c) { CARRY[(size_t)(c0 + c) * 512] = h; h = av[c] * h + hv[c]; }
            }
            KOUT[OFF_HP + (size_t)(l * 2 + seq) * 512 + tid] = h;
        }
    }
}

#define ATT_GLD(dst, ptr, OFF) asm volatile("global_load_dwordx4 %0, %1, off offset:" #OFF : "=v"(dst) : "v"(ptr) : "memory")
#define ATT_WAIT(N, K, V) asm volatile("s_waitcnt vmcnt(" #N ")" : "+v"(K[0]), "+v"(K[1]), "+v"(K[2]), "+v"(K[3]), "+v"(V[0]), "+v"(V[1]), "+v"(V[2]), "+v"(V[3]) :: "memory")
__device__ __forceinline__ void attn_item(const Params& P, int l, int item, LAS unsigned char* lds, int wave, int lane_) {
    int lane = lane_; asm volatile("" : "+v"(lane));
    const bf16_t* QKG = (const bf16_t*)(KWS + WS_QKG); const bf16_t* VT = (const bf16_t*)(KWS + WS_VT);
    const bf16_t* KC = (const bf16_t*)(KWS + WS_KC); const bf16_t* VTC = (const bf16_t*)(KWS + WS_VTC);
    bf16_t* AR = (bf16_t*)(KWS + WS_H);
    const LAS float* tab = (const LAS float*)(lds + LDS_TAB_OFF) + wave * LDS_TAB_STRIDE;
    const int sc_ = item >> 1, qh = item & 1;
    const int seq = sc_ < 256 ? (sc_ >> 7) : 2 + (sc_ - 256), chunk = sc_ < 256 ? (sc_ & 127) : 8;
    const int h = wave, i32 = lane & 31, hi = lane >> 5;
    const int rowbase = seq < 2 ? seq * 8192 + chunk * 64 : MP + (seq - 2) * 64;
    const int qrow = rowbase + 32 * qh + i32;
    const int pi = (i32 & 0x13) | ((i32 & 4) << 1) | ((i32 & 8) >> 1);
    bf16x8 bq[4];
#pragma unroll
    for (int ks = 0; ks < 4; ++ks) bq[ks] = *(const GAS bf16x8*)(QKG + (size_t)qrow * NMAIN + h * 64 + 16 * ks + 8 * hi);
    f32x16 o0, o1;
#pragma unroll
    for (int r = 0; r < 16; ++r) { o0[r] = 0.f; o1[r] = 0.f; }
    float mrun = -1e30f, lrun = 0.f;
    const int jstart = (seq < 2 && chunk < 8) ? 2 * (8 - chunk) : 0;
    const int tq = 32 * qh + i32;

    const bf16_t* KFb = (const bf16_t*)(KWS + WS_KF);
    auto issue = [&](int j_, bf16x8 (&KF)[4], bf16x8 (&VF)[4]) {
        const bf16_t* kp; const bf16_t* vp;
        if (seq >= 2 && j_ < 16) { const size_t o = ((size_t)(((seq - 2) * 16 + j_) * 8 + h) * 4) * 512 + lane * 8; kp = KC + o; vp = VTC + o; }
        else { const int tok0 = seq < 2 ? seq * 8192 + 64 * (chunk - 8) + 32 * j_ : MP + (seq - 2) * 64 + 32 * (j_ - 16);
            const size_t o = ((size_t)((tok0 >> 5) * 8 + h) * 4) * 512 + lane * 8; kp = KFb + o; vp = VT + o; }
        ATT_GLD(KF[0], kp, 0); ATT_GLD(KF[1], kp, 1024); ATT_GLD(KF[2], kp, 2048); ATT_GLD(KF[3], kp, 3072);
        ATT_GLD(VF[0], vp, 0); ATT_GLD(VF[1], vp, 1024); ATT_GLD(VF[2], vp, 2048); ATT_GLD(VF[3], vp, 3072);
    };
    auto compute = [&](int j, const bf16x8 (&kf)[4], const bf16x8 (&vf)[4]) {
        f32x16 s;
#pragma unroll
        for (int r = 0; r < 16; ++r) s[r] = 0.f;
#pragma unroll
        for (int ks = 0; ks < 4; ++ks) s = __builtin_amdgcn_mfma_f32_32x32x16_bf16(kf[ks], bq[ks], s, 0, 0, 0);
        float mt = -1e30f;
        if (j < 8) {
            const float bc = tab[512];
#pragma unroll
            for (int r = 0; r < 16; ++r) { s[r] = s[r] * 0.125f + bc; mt = fmaxf(mt, s[r]); }
        } else {
            const LAS float* tp = tab + (768 + tq - 32 * j - 8 * hi);
            float bv[16];
#pragma unroll
            for (int r = 0; r < 16; ++r) bv[r] = tp[-(16 * (r >> 3) + (r & 7))];
#pragma unroll
            for (int r = 0; r < 16; ++r) { s[r] = s[r] * 0.125f + bv[r]; mt = fmaxf(mt, s[r]); }
        }
        mt = fmaxf(mt, __shfl_xor(mt, 32));
        const float mnew = fmaxf(mrun, mt), alpha = __expf(mrun - mnew);
        float ps = 0.f;
#pragma unroll
        for (int r = 0; r < 16; ++r) { s[r] = __expf(s[r] - mnew); ps += s[r]; }
        lrun = lrun * alpha + ps; mrun = mnew;
#pragma unroll
        for (int r = 0; r < 16; ++r) { o0[r] *= alpha; o1[r] *= alpha; }
        u32x4 p0, p1;
        p0.x = cvt_pk_bf16(s[0], s[1]); p0.y = cvt_pk_bf16(s[2], s[3]); p0.z = cvt_pk_bf16(s[4], s[5]); p0.w = cvt_pk_bf16(s[6], s[7]);
        p1.x = cvt_pk_bf16(s[8], s[9]); p1.y = cvt_pk_bf16(s[10], s[11]); p1.z = cvt_pk_bf16(s[12], s[13]); p1.w = cvt_pk_bf16(s[14], s[15]);
        const bf16x8 pb0 = __builtin_bit_cast(bf16x8, p0), pb1 = __builtin_bit_cast(bf16x8, p1);
        o0 = __builtin_amdgcn_mfma_f32_32x32x16_bf16(vf[0], pb0, o0, 0, 0, 0);
        o0 = __builtin_amdgcn_mfma_f32_32x32x16_bf16(vf[1], pb1, o0, 0, 0, 0);
        o1 = __builtin_amdgcn_mfma_f32_32x32x16_bf16(vf[2], pb0, o1, 0, 0, 0);
        o1 = __builtin_amdgcn_mfma_f32_32x32x16_bf16(vf[3], pb1, o1, 0, 0, 0);
    };
    bf16x8 ka[4], va[4], kb[4], vb[4];
    asm volatile("" :: "v"(bq[0]), "v"(bq[1]), "v"(bq[2]), "v"(bq[3]));
    int j = jstart;
    issue(j, ka, va);
#pragma unroll 1
    for (;;) {
        issue(j + 1, kb, vb); ATT_WAIT(8, ka, va);
        compute(j, ka, va);
        ++j;
        issue(j + 1 < 18 ? j + 1 : 17, ka, va); ATT_WAIT(8, kb, vb);
        compute(j, kb, vb);
        ++j;
        if (j >= 18) break;
    }
    ATT_WAIT(0, ka, va);
    const float inv = 1.0f / (lrun + __shfl_xor(lrun, 32));
    bf16_t* orow = AR + (size_t)qrow * DM + h * 64 + 4 * hi;
#pragma unroll
    for (int g = 0; g < 4; ++g) {
        u32x2 w0, w1;
        w0.x = cvt_pk_bf16(o0[4 * g] * inv, o0[4 * g + 1] * inv); w0.y = cvt_pk_bf16(o0[4 * g + 2] * inv, o0[4 * g + 3] * inv);
        w1.x = cvt_pk_bf16(o1[4 * g] * inv, o1[4 * g + 1] * inv); w1.y = cvt_pk_bf16(o1[4 * g + 2] * inv, o1[4 * g + 3] * inv);
        *(u32x2*)(orow + 8 * g) = w0; *(u32x2*)(orow + 32 + 8 * g) = w1;
    }
}

__device__ __forceinline__ void rnn_final_phase(const Params& P, int l, int gtid, int NT) {
    const bf16_t* QKG = (const bf16_t*)(KWS + WS_QKG); const bf16_t* HL = (const bf16_t*)(KWS + WS_HL); const bf16_t* CA = (const bf16_t*)(KWS + WS_CA);
    const float* CARRY = (const float*)(KWS + WS_CARRY); const float* h0 = KIN(7) + (size_t)l * 16 * 512;
    bf16_t* RN = (bf16_t*)(KWS + WS_H) + 512;
#pragma unroll 2
    for (int it = gtid; it < MT * 64; it += NT) {
        const int row = it >> 6, c8 = (it & 63) * 8;
        const float* cp = row < MP ? CARRY + ((size_t)((row >> 13) * 128 + ((row & 8191) >> 6))) * 512 + c8 : h0 + (size_t)((row - MP) >> 6) * 512 + c8;
        const f32x4 ca0 = *(const f32x4*)cp, ca1 = *(const f32x4*)(cp + 4);
        const u32x4 hc0 = *(const u32x4*)((const unsigned*)HL + (size_t)row * 512 + c8), hc1 = *(const u32x4*)((const unsigned*)HL + (size_t)row * 512 + c8 + 4), rg = *(const u32x4*)(QKG + (size_t)row * NMAIN + 1536 + c8);
        float o[8];
#pragma unroll
        for (int e = 0; e < 4; ++e) {
            const float c_lo = e < 2 ? ca0[2 * e] : ca1[2 * e - 4], c_hi = e < 2 ? ca0[2 * e + 1] : ca1[2 * e - 3];
            const unsigned w_lo = e < 2 ? hc0[2 * e] : hc1[2 * e - 4], w_hi = e < 2 ? hc0[2 * e + 1] : hc1[2 * e - 3];
            o[2 * e] = (bflo(w_lo) + bfhi(w_lo) * c_lo) * gelu_tanh(bflo(rg[e]));
            o[2 * e + 1] = (bflo(w_hi) + bfhi(w_hi) * c_hi) * gelu_tanh(bfhi(rg[e]));
        }
        u32x4 w; w.x = cvt_pk_bf16(o[0], o[1]); w.y = cvt_pk_bf16(o[2], o[3]); w.z = cvt_pk_bf16(o[4], o[5]); w.w = cvt_pk_bf16(o[6], o[7]);
        *(u32x4*)(RN + (size_t)row * DM + c8) = w;
    }
}

__device__ __forceinline__ void act_phase(const Params& P, int l, int hf, int gtid, int NT) {
    const bf16_t* UP = (const bf16_t*)(KWS + WS_UP); bf16_t* ACT = (bf16_t*)(KWS + WS_ACT);
    const float* cw = KIN(27) + (size_t)l * 3 * DUP; const float* cbp = KIN(28) + (size_t)l * DUP;
    for (int it = gtid; it < (MT / 16) * (HF / 8); it += NT) {
        const int rc = it / (HF / 8), cg8 = it % (HF / 8), j0 = cg8 * 8, row0 = rc * 16;
        const int gv = hf * HF + j0, gg = DFF + hf * HF + j0;
        float wv[3][8], wg[3][8], bv[8], bg[8];
#pragma unroll
        for (int k = 0; k < 3; ++k)
#pragma unroll
            for (int e = 0; e < 8; ++e) { wv[k][e] = cw[k * DUP + gv + e]; wg[k][e] = cw[k * DUP + gg + e]; }
#pragma unroll
        for (int e = 0; e < 8; ++e) { bv[e] = cbp[gv + e]; bg[e] = cbp[gg + e]; }
        float v0[8], v1[8], g0[8], g1[8];
        const int tseq = row0 < MP ? (row0 & 8191) : ((row0 - MP) & 63);
        if (tseq == 0) {
            if (row0 < MP) {
#pragma unroll
                for (int e = 0; e < 8; ++e) { v0[e] = v1[e] = g0[e] = g1[e] = 0.f; }
            } else {
                const float* st = KIN(8) + ((size_t)(l * 16 + ((row0 - MP) >> 6)) * 2) * DUP;
#pragma unroll
                for (int e = 0; e < 8; ++e) { v0[e] = st[gv + e]; v1[e] = st[DUP + gv + e]; g0[e] = st[gg + e]; g1[e] = st[DUP + gg + e]; }
            }
        } else {
            const u32x4 a0 = *(const u32x4*)(UP + (size_t)(row0 - 2) * HUP + j0), a1 = *(const u32x4*)(UP + (size_t)(row0 - 1) * HUP + j0);
            const u32x4 b0 = *(const u32x4*)(UP + (size_t)(row0 - 2) * HUP + HF + j0), b1 = *(const u32x4*)(UP + (size_t)(row0 - 1) * HUP + HF + j0);
#pragma unroll
            for (int e = 0; e < 4; ++e) { v0[2 * e] = bflo(a0[e]); v0[2 * e + 1] = bfhi(a0[e]); v1[2 * e] = bflo(a1[e]); v1[2 * e + 1] = bfhi(a1[e]);
                g0[2 * e] = bflo(b0[e]); g0[2 * e + 1] = bfhi(b0[e]); g1[2 * e] = bflo(b1[e]); g1[2 * e + 1] = bfhi(b1[e]); }
        }
#pragma unroll 4
        for (int t = 0; t < 16; ++t) {
            const size_t row = row0 + t;
            const u32x4 a2 = *(const u32x4*)(UP + row * HUP + j0), b2 = *(const u32x4*)(UP + row * HUP + HF + j0);
            float v2[8], g2[8], o[8];
#pragma unroll
            for (int e = 0; e < 4; ++e) { v2[2 * e] = bflo(a2[e]); v2[2 * e + 1] = bfhi(a2[e]); g2[2 * e] = bflo(b2[e]); g2[2 * e + 1] = bfhi(b2[e]); }
#pragma unroll
            for (int e = 0; e < 8; ++e) {
                const float val = bv[e] + wv[0][e] * v0[e] + wv[1][e] * v1[e] + wv[2][e] * v2[e];
                const float gt = bg[e] + wg[0][e] * g0[e] + wg[1][e] * g1[e] + wg[2][e] * g2[e];
                o[e] = val * gelu_tanh(gt);
                v0[e] = v1[e]; v1[e] = v2[e]; g0[e] = g1[e]; g1[e] = g2[e];
            }
            u32x4 w; w.x = cvt_pk_bf16(o[0], o[1]); w.y = cvt_pk_bf16(o[2], o[3]); w.z = cvt_pk_bf16(o[4], o[5]); w.w = cvt_pk_bf16(o[6], o[7]);
            *(u32x4*)(ACT + row * DFF + hf * HF + j0) = w;
        }
    }
}


#define XB_TMO      128
#define XB_XCNT(j)  (256  + 64 * (j))
#define XB_XSUB(j)  (1280 + 64 * (j))
#define XB_XGEN(j)  (2304 + 64 * (j))
#define XB_TOP      3328
#define XB_TOPGEN   3392
#define XCD_BAR_WORDS 3456
#define XB_SPIN_CAP (1u << 18)
__device__ __forceinline__ unsigned xb_ld(unsigned* p)              { return __hip_atomic_load(p, __ATOMIC_RELAXED, __HIP_MEMORY_SCOPE_AGENT); }
__device__ __forceinline__ unsigned xb_add(unsigned* p, unsigned v) { return __hip_atomic_fetch_add(p, v, __ATOMIC_RELAXED, __HIP_MEMORY_SCOPE_AGENT); }
__device__ __forceinline__ unsigned xb_xcc_id() { return (unsigned)__builtin_amdgcn_s_getreg((3 << 11) | 20) & 0xFu; }
#define XB_SPIN(cond, bar) do { unsigned _sp = 0; while (cond) { __builtin_amdgcn_s_sleep(1); \
    if ((++_sp & 255u) == 0u) { if (xb_ld(&(bar)[XB_TMO])) break; if (_sp > XB_SPIN_CAP) { atomicAdd(&(bar)[XB_TMO], 1u); break; } } } } while (0)
struct XcdBarrier { unsigned* bar; unsigned x; volatile LAS unsigned* st; int wv; };
__device__ __forceinline__ XcdBarrier xcd_barrier_post(unsigned* bar, volatile LAS unsigned* st, int wv) {
    XcdBarrier b; b.bar = bar; b.x = xb_xcc_id(); b.st = st; b.wv = wv;
    if (wv == 0 && lane_id() == 0) (void)xb_add(&bar[XB_XCNT(b.x)], 1u);
    return b;
}
__device__ __forceinline__ void xcd_barrier_complete(unsigned* bar, unsigned x, unsigned& nloc, unsigned& nx) {
    const unsigned G = gridDim.x * gridDim.y * gridDim.z;
    unsigned sum, cnt, mine, sp = 0u;
    for (;;) {
        sum = 0u; cnt = 0u; mine = 0u;
#pragma unroll
        for (unsigned j = 0; j < 16; ++j) { const unsigned c = xb_ld(&bar[XB_XCNT(j)]); sum += c; cnt += (c > 0u) ? 1u : 0u; mine = (j == x) ? c : mine; }
        if (sum == G) break;
        __builtin_amdgcn_s_sleep(1);
        if ((++sp & 255u) == 0u) { if (xb_ld(&bar[XB_TMO])) break; if (sp > XB_SPIN_CAP) { atomicAdd(&bar[XB_TMO], 1u); break; } }
    }
    nloc = mine > 0u ? mine : 1u; nx = cnt > 0u ? cnt : 1u;
}
template <bool FIRST>
__device__ __forceinline__ void xcd_barrier_t(const XcdBarrier& b) {
    asm volatile("s_waitcnt vmcnt(0)" ::: "memory");
    __syncthreads();
    if (b.wv == 0 && lane_id() == 0) {
        unsigned* bar = b.bar;
        __builtin_amdgcn_s_waitcnt(0);
        unsigned nloc = b.st[0], nx = b.st[1];
        if constexpr (FIRST) { if (nloc == 0u) { xcd_barrier_complete(bar, b.x, nloc, nx); b.st[0] = nloc; b.st[1] = nx; } }
        const unsigned old = xb_add(&bar[XB_XSUB(b.x)], 1u);
        const unsigned gen = old / nloc;
        if (old + 1u == (gen + 1u) * nloc) {
            __builtin_amdgcn_fence(__ATOMIC_RELEASE, "agent");
            asm volatile("s_waitcnt vmcnt(0)" ::: "memory");
            const unsigned og = xb_add(&bar[XB_TOP], 1u);
            const unsigned tg = og / nx;
            if (og + 1u == (tg + 1u) * nx) xb_add(&bar[XB_TOPGEN], 1u);
            else XB_SPIN(xb_ld(&bar[XB_TOPGEN]) == tg, bar);
            __builtin_amdgcn_fence(__ATOMIC_ACQUIRE, "agent");
            xb_add(&bar[XB_XGEN(b.x)], 1u);
            asm volatile("s_waitcnt vmcnt(0)" ::: "memory");
        } else {
            XB_SPIN(xb_ld(&bar[XB_XGEN(b.x)]) == gen, bar);
            __builtin_amdgcn_fence(__ATOMIC_ACQUIRE, "agent");
            asm volatile("s_waitcnt vmcnt(0)" ::: "memory");
        }
    }
    __syncthreads();
}

#ifndef PHMASK
#define PHMASK 0xFFFF
#endif
#define PH(b) if constexpr ((PHMASK >> (b)) & 1)
#ifndef REPMASK
#define REPMASK 0
#endif
#ifndef RNNREP
#define RNNREP 1
#endif
#ifndef ATTREP
#define ATTREP 1
#endif
#ifndef ATT2X
#define ATT2X 1
#endif
#ifndef SYNCREP
#define SYNCREP 1
#endif
#define REPS(b) ((((REPMASK) >> (b)) & 1) ? 2 : 1)
#define RLOOP(b)
#define GSYNC() xcd_barrier_t<false>(xbar)
__global__ void __launch_bounds__(512) fwd_megakernel(Params P) {
    extern __shared__ __attribute__((aligned(16))) unsigned char lds_raw[];
    cg::grid_group grid = cg::this_grid();
    LAS unsigned char* lds = (LAS unsigned char*)lds_raw;
#define THREAD_IDS() const int lane = lane_id(), wave = wave_s, tid = wave_s * 64 + lane; \
    const int gw = blockIdx.x * 8 + wave, gtid = blockIdx.x * 512 + tid; (void)gw; (void)gtid; (void)lane
    const int G = gridDim.x, NGW = G * 8, NT = G * 512;
    unsigned char* ws = KWS;
    unsigned* ctl = (unsigned*)(ws + WS_CTL);
    float* mods = (float*)(ws + WS_MODS);
    float* X = KOUT + OFF_Y;
    bf16_t* Hb = (bf16_t*)(ws + WS_H);

    const int wave_s = __builtin_amdgcn_readfirstlane((int)threadIdx.x >> 6);
    { const int l0_ = lane_id(); if (wave_s == 0 && l0_ < 16) ((LAS unsigned*)(lds + LDS_MISC_OFF))[l0_] = 0u; }
    __syncthreads();
    const XcdBarrier xbar = xcd_barrier_post(ctl + 4096, (volatile LAS unsigned*)(lds + LDS_MISC_OFF + 16), wave_s);
    {
    THREAD_IDS();
    RLOOP(0) mods_phase(P, lds, tid, wave, lane);
    RLOOP(1) convert_layer(P, 0, lds, gw, NGW, wave, lane);
    }
    xcd_barrier_t<true>(xbar);
    if (ws == nullptr) grid.sync();

#pragma unroll 1
    for (int l_ = 0; l_ < 2; ++l_) {
        int l = l_; asm volatile("" : "+s"(l));
        THREAD_IDS();
        unsigned char* ws = KWS; unsigned* ctl = (unsigned*)(ws + WS_CTL); float* mods = (float*)(ws + WS_MODS); float* X = KOUT + OFF_Y; bf16_t* Hb = (bf16_t*)(ws + WS_H);
        if (l == 1) { RLOOP(1) convert_layer(P, 1, lds, gw, NGW, wave, lane); }
        RLOOP(2) { norm_phase(l == 0 ? KIN(0) : X, l == 0 ? KIN(1) : X + (size_t)MP * DM, KIN(11) + l * DM, mods + (size_t)(l * 2 + 0) * 18 * 3072, Hb, l == 0 ? X : nullptr, (const bf16_t*)(ws + WS_QKG), l == 0 ? 0 : 11, gw, NGW, lane);
        GSYNC(); }
        RLOOP(3) {
            pg8::Sched<68, 16, true> S; S.A = (const char*)(ws + WS_H); S.B = (const char*)(ws + WS_WIN);
            S.tstep = (size_t)256 * DM * 2; S.G = G; S.c = blockIdx.x; S.nt = DM / 64;
            EpiG1 E{(bf16_t*)(ws + WS_QKG), (bf16_t*)(ws + WS_VT), (bf16_t*)(ws + WS_KF), KOUT, l};
            pg8::gemm_phase<EpiG1>(lds, DM, S, E, wave_s);
            GSYNC();
        }
        RLOOP(4) {
            const int lane = lane_id(), tid = wave_s * 64 + lane;
            const float* tb = KIN(13) + (size_t)l * 513 * 8;
            for (int i = tid; i < 832 * 8; i += 512) { const int idx = i >> 3, hh = i & 7; ((LAS float*)(lds + LDS_TAB_OFF))[hh * LDS_TAB_STRIDE + idx] = tb[(idx > 512 ? 512 : idx) * 8 + hh]; }
            volatile LAS int* qslot = (volatile LAS int*)(lds + LDS_MISC_OFF);
            int nxt = 0;
            if (tid == 0) nxt = (int)atomicAdd(ctl + 64 * (l + 1), 1u);
            for (;;) {
                __syncthreads();
                if (tid == 0) qslot[0] = nxt;
                __syncthreads();
                const int it = qslot[0];
                if (it >= NITEM_RNN + ATT2X * NITEM_ATT) break;
                if (tid == 0) nxt = (int)atomicAdd(ctl + 64 * (l + 1), 1u);
                if (it < NITEM_RNN) { rnn_item(P, l, it, lds, ctl + 64 * (16 + l * 2), tid, wave, lane); }
                else attn_item(P, l, NITEM_ATT - 1 - (it - NITEM_RNN) % NITEM_ATT, lds, wave, lane);
            }
            GSYNC();
        }
        RLOOP(5) { rnn_final_phase(P, l, blockIdx.x * 512 + wave_s * 64 + lane_id(), NT);
        GSYNC(); }
        RLOOP(6) {
            pg8::SchedPair S; S.A = (const char*)(ws + WS_H); S.B = (const char*)(ws + WS_WBR);
            S.tstep = (size_t)256 * DM * 2; S.G = G; S.c = blockIdx.x;
            EpiBr E{(const bf16_t*)(ws + WS_QKG), (bf16_t*)(ws + WS_MG), (bf16_t*)(ws + WS_VT)};
            pg8::gemm_phase<EpiBr>(lds, DM, S, E, wave_s);
            GSYNC();
        }
        RLOOP(7) {
            pg8::SchedWout S; S.A = (const char*)(ws + WS_MG); S.TS = (const char*)(ws + WS_VT); S.B = (const char*)(ws + WS_WOUT);
            S.tstep = (size_t)256 * DM * 2; S.G = G; S.c = blockIdx.x;
            float* Xo = X;
            EpiRes E{l == 0 ? KIN(0) : X, l == 0 ? KIN(1) : X + (size_t)MP * DM, Xo, mods + (size_t)(l * 2 + 0) * 18 * 3072 + 2048, (bf16_t*)(ws + WS_QKG)};
            pg8::gemm_phase<EpiRes>(lds, DM, S, E, wave_s);
            GSYNC();
        }
        RLOOP(2) { norm_phase(X, X + (size_t)MP * DM, KIN(25) + l * DM, mods + (size_t)(l * 2 + 1) * 18 * 3072, Hb, nullptr, (const bf16_t*)(ws + WS_QKG), 8, gw, NGW, lane_id());
        GSYNC(); }
        RLOOP(8) {
            pg8::Sched<68, 22, false> S; S.A = (const char*)(ws + WS_H); S.B = (const char*)(ws + WS_WUP);
            S.tstep = (size_t)256 * DM * 2; S.G = G; S.c = blockIdx.x; S.nt = DM / 64;
            EpiUpAct E{(bf16_t*)(ws + WS_ACT), KOUT, (float*)(ws + WS_HEAD), (float*)(ws + WS_TAIL), KIN(27) + (size_t)l * 3 * DUP, KIN(28) + (size_t)l * DUP, KIN(8), (LAS float*)(lds + LDS_TAB_OFF), l};
            pg8::gemm_phase<EpiUpAct>(lds, DM, S, E, wave_s);
            GSYNC();
        }
        RLOOP(10) {
            pg8::SchedSplit<11> S; S.A = (const char*)(ws + WS_ACT); S.B = (const char*)(ws + WS_WDN);
            S.tstep = (size_t)256 * DFF * 2; S.G = G; S.c = blockIdx.x; S.K = DFF;
            { pg8::Unit u0; if (S.next(0, u0) && u0.kind == 0 && (u0.pm & 31) != 0) ffn_fix_tile(P, l, u0.pm, wave_s * 64 + lane_id());
              asm volatile("s_waitcnt vmcnt(0)" ::: "memory"); __syncthreads(); }
            float* Xo = X;
            EpiRes E{X, X + (size_t)MP * DM, Xo, mods + (size_t)(l * 2 + 1) * 18 * 3072 + 2048, (bf16_t*)(ws + WS_QKG)};
            pg8::gemm_phase<EpiRes>(lds, DFF, S, E, wave_s);
            GSYNC();
        }
    }
    {
        THREAD_IDS();
        const float* g = KIN(30);
        for (int row = gw; row < MT; row += NGW) {
            float* xr = X + (size_t)row * DM;
            f32x4 v[4]; float s = 0.f;
#pragma unroll
            for (int j = 0; j < 4; ++j) {
                v[j] = *(const f32x4*)(xr + 4 * lane + 256 * j);
                if (row >= MP) { const bf16_t* pp = (const bf16_t*)(ws + WS_QKG) + (size_t)(row - MP) * DM + 4 * lane + 256 * j;
                    for (int sl = 0; sl < 11; ++sl) { const u32x2 w = *(const u32x2*)(pp + (size_t)sl * 1024 * DM); v[j][0] += bflo(w.x); v[j][1] += bfhi(w.x); v[j][2] += bflo(w.y); v[j][3] += bfhi(w.y); } }
                s += (v[j][0] * v[j][0] + v[j][1] * v[j][1]) + (v[j][2] * v[j][2] + v[j][3] * v[j][3]);
            }
            const float rstd = rsqrtf(wave_sum(s) * (1.0f / DM) + 1e-6f);
#pragma unroll
            for (int j = 0; j < 4; ++j) { const int c = 4 * lane + 256 * j; *(f32x4*)(xr + c) = v[j] * rstd * *(const f32x4*)(g + c); }
        }
    }
}

extern "C" void kernel_launch(void* const* d_in, const int* in_sizes, int n_in, void* d_out, int out_size, void* d_ws, size_t ws_size, hipStream_t stream) {
    static int grid = 0;
    if (grid == 0) {
        if (n_in != 31 || ws_size < WS_NEED) { fprintf(stderr, "kernel_launch: unexpected n_in %d / ws %zu\n", n_in, ws_size); grid = -1; return; }
        int dev = 0, cus = 0, per_cu = 0;
        (void)hipGetDevice(&dev);
        (void)hipDeviceGetAttribute(&cus, hipDeviceAttributeMultiprocessorCount, dev);
        if (hipFuncSetAttribute((const void*)fwd_megakernel, hipFuncAttributeMaxDynamicSharedMemorySize, LDS_BYTES) != hipSuccess) { fprintf(stderr, "kernel_launch: hipFuncSetAttribute failed\n"); grid = -1; return; }
        if (hipOccupancyMaxActiveBlocksPerMultiprocessor(&per_cu, (const void*)fwd_megakernel, 512, LDS_BYTES) != hipSuccess || per_cu < 1) { fprintf(stderr, "kernel_launch: occupancy query gave %d\n", per_cu); grid = -1; return; }
        grid = cus;
    }
    if (grid < 0) return;
    (void)hipMemsetAsync((char*)d_ws + WS_CTL, 0, 65536, stream);
    Params p{};
    for (int i = 0; i < 31; ++i) p.in[i] = (const float*)d_in[i];
    p.out = (float*)d_out; p.ws = (unsigned char*)d_ws;
    void* args[] = {&p};
    hipError_t e = hipLaunchCooperativeKernel((void*)fwd_megakernel, dim3(grid), dim3(512), args, LDS_BYTES, stream);
    if (e != hipSuccess) fprintf(stderr, "cooperative launch failed: %s (grid %d)\n", hipGetErrorString(e), grid);
}
```
